# Optimizing an MI355X kernel written in HIP

```python
import math
import jax, jax.numpy as jnp
from jax import lax
import numpy as np

D_MODEL = 2048
BATCH = 1
SEQ = 8192
DEPTH = 4

HEAD_DIM = 64
SGU_WIDTH = D_MODEL // 2
N_SGU_HEADS = SGU_WIDTH // HEAD_DIM
SGU_HEAD_DIM = SGU_WIDTH // N_SGU_HEADS
CHUNK = 128
ATTN_WIDTH = D_MODEL - SGU_WIDTH
N_Q_HEADS = ATTN_WIDTH // HEAD_DIM
N_KV_HEADS = 4
GROUP = N_Q_HEADS // N_KV_HEADS
WINDOW = 128
BLOCK = 128
NUM_BUCKETS = 32
MAX_DISTANCE = 128
IN_WIDTH = 2 * SGU_WIDTH + N_Q_HEADS * HEAD_DIM + 2 * N_KV_HEADS * HEAD_DIM
D_FF = -(-8 * D_MODEL // (3 * 256)) * 256
EPS = 1e-6
NEG_INF = -1e30

kernel_name = "hybrid_sgu_swa_sink_trunk"


def rms_norm(x, g):
    xf = x.astype(jnp.float32)
    y = xf * lax.rsqrt(jnp.mean(xf * xf, axis=-1, keepdims=True) + EPS)
    return (y * g.astype(jnp.float32)).astype(x.dtype)


def t5_causal_bucket(dist):
    n = jnp.maximum(dist, 0)
    max_exact = NUM_BUCKETS // 2
    nf = jnp.maximum(n, 1).astype(jnp.float32)
    large = max_exact + (jnp.log(nf / max_exact) / math.log(MAX_DISTANCE / max_exact)
                         * (NUM_BUCKETS - max_exact)).astype(jnp.int32)
    large = jnp.minimum(large, NUM_BUCKETS - 1)
    return jnp.where(n < max_exact, n, large)


def chunked_sgu(z, v_norm_g, w_s, b_s):
    b, s, _ = z.shape
    u, v = jnp.split(z, 2, axis=-1)
    v = v.reshape(b, s // CHUNK, CHUNK, N_SGU_HEADS, SGU_HEAD_DIM)
    v = rms_norm(v, v_norm_g)
    w = w_s * jnp.tril(jnp.ones((CHUNK, CHUNK), w_s.dtype))
    gate = jnp.einsum('hts,bcshd->bcthd', w, v) + b_s.T[None, None, :, :, None]
    return u * gate.reshape(b, s, SGU_WIDTH)


def swa_sink_attention(q, k, v, q_norm_g, k_norm_g, sinks, rel_bias):
    b, s, _ = q.shape
    nb = s // BLOCK
    q = rms_norm(q.reshape(b, nb, BLOCK, N_KV_HEADS, GROUP, HEAD_DIM), q_norm_g)
    k = rms_norm(k.reshape(b, nb, BLOCK, N_KV_HEADS, HEAD_DIM), k_norm_g)
    v = v.reshape(b, nb, BLOCK, N_KV_HEADS, HEAD_DIM)

    def band(t):
        prev = jnp.concatenate([jnp.zeros_like(t[:, :1]), t[:, :-1]], axis=1)
        return jnp.concatenate([prev, t], axis=2)

    kb, vb = band(k), band(v)
    scale = 1.0 / math.sqrt(HEAD_DIM)
    scores = jnp.einsum('bnqkgd,bnskd->bnkgqs', q, kb).astype(jnp.float32) * scale

    qi = jnp.arange(BLOCK)[:, None]
    kj = jnp.arange(2 * BLOCK)[None, :]
    dist = qi + BLOCK - kj
    bias = rel_bias[t5_causal_bucket(dist)].astype(jnp.float32)
    bias = jnp.transpose(bias, (2, 0, 1)).reshape(N_KV_HEADS, GROUP, BLOCK, 2 * BLOCK)
    in_window = (dist >= 0) & (dist < WINDOW)
    key_pos = jnp.arange(nb)[:, None] * BLOCK - BLOCK + kj
    valid = in_window[None] & (key_pos >= 0)[:, None, :]
    scores = jnp.where(valid[None, :, None, None], scores + bias, NEG_INF)

    sink = jnp.broadcast_to(
        sinks.astype(jnp.float32).reshape(N_KV_HEADS, GROUP)[None, None, :, :, None, None],
        scores.shape[:-1] + (1,))
    probs = jax.nn.softmax(jnp.concatenate([scores, sink], axis=-1), axis=-1)[..., :-1]
    out = jnp.einsum('bnkgqs,bnskd->bnqkgd', probs.astype(vb.dtype), vb)
    return out.reshape(b, s, ATTN_WIDTH)


def setup_inputs(seed: int = 0) -> dict:
    key = jax.random.key(seed)
    ks = jax.random.split(key, 20)
    f32 = jnp.float32
    nrm = lambda k, shape, sc: jax.random.normal(k, shape, f32) * sc
    gain = lambda k, shape: 1.0 + 0.02 * jax.random.normal(k, shape, f32)
    return {
        "x": jax.random.normal(ks[0], (BATCH, SEQ, D_MODEL), f32),
        "rel_bias": nrm(ks[1], (NUM_BUCKETS, N_Q_HEADS), 0.1),
        "norm1_g": gain(ks[2], (DEPTH, D_MODEL)),
        "w_in": nrm(ks[3], (DEPTH, D_MODEL, IN_WIDTH), D_MODEL ** -0.5),
        "sgu_norm_g": gain(ks[4], (DEPTH, N_SGU_HEADS, SGU_HEAD_DIM)),
        "sgu_w": nrm(ks[5], (DEPTH, N_SGU_HEADS, CHUNK, CHUNK), CHUNK ** -0.5),
        "sgu_b": gain(ks[6], (DEPTH, N_SGU_HEADS, CHUNK)),
        "q_norm_g": gain(ks[7], (DEPTH, HEAD_DIM)),
        "k_norm_g": gain(ks[8], (DEPTH, HEAD_DIM)),
        "sinks": nrm(ks[9], (DEPTH, N_Q_HEADS), 0.5),
        "out_norm_a": gain(ks[10], (DEPTH, SGU_WIDTH)),
        "out_norm_b": gain(ks[11], (DEPTH, ATTN_WIDTH)),
        "w_out": nrm(ks[12], (DEPTH, D_MODEL, D_MODEL), D_MODEL ** -0.5),
        "norm2_g": gain(ks[13], (DEPTH, D_MODEL)),
        "w_gate": nrm(ks[14], (DEPTH, D_MODEL, D_FF), D_MODEL ** -0.5),
        "w_up": nrm(ks[15], (DEPTH, D_MODEL, D_FF), D_MODEL ** -0.5),
        "w_down": nrm(ks[16], (DEPTH, D_FF, D_MODEL), D_FF ** -0.5),
    }


def reference(x, rel_bias, norm1_g, w_in, sgu_norm_g, sgu_w, sgu_b, q_norm_g, k_norm_g,
              sinks, out_norm_a, out_norm_b, w_out, norm2_g, w_gate, w_up, w_down):
    q_end = 2 * SGU_WIDTH + N_Q_HEADS * HEAD_DIM
    k_end = q_end + N_KV_HEADS * HEAD_DIM
    for l in range(DEPTH):
        h = rms_norm(x, norm1_g[l])
        z = h @ w_in[l]
        z_sgu = jax.nn.gelu(z[..., :2 * SGU_WIDTH], approximate=False)
        out_a = chunked_sgu(z_sgu, sgu_norm_g[l], sgu_w[l], sgu_b[l])
        out_b = swa_sink_attention(z[..., 2 * SGU_WIDTH:q_end], z[..., q_end:k_end],
                                   z[..., k_end:], q_norm_g[l], k_norm_g[l], sinks[l],
                                   rel_bias)
        mixed = jnp.concatenate([rms_norm(out_a, out_norm_a[l]),
                                 rms_norm(out_b, out_norm_b[l])], axis=-1)
        x = x + mixed @ w_out[l]
        h2 = rms_norm(x, norm2_g[l])
        x = x + (jax.nn.silu(h2 @ w_gate[l]) * (h2 @ w_up[l])) @ w_down[l]
    return x
```

```cpp
#include <hip/hip_runtime.h>
#include <hip/hip_cooperative_groups.h>
#include <cstdio>
#include <cstdint>
namespace cg = cooperative_groups;
namespace pg8 {
#define PG8_LAS __attribute__((address_space(3)))
typedef unsigned short bf16_t;
typedef short bf16x8 __attribute__((ext_vector_type(8)));
typedef float f32x4 __attribute__((ext_vector_type(4)));
typedef unsigned u32x4 __attribute__((ext_vector_type(4)));
constexpr int BM = 256, BK = 64, HALF = 128, HTB = HALF * BK * 2  , STAGE_BYTES = 8 * HTB, NXCD = 8, WGM = 8;

__host__ __device__ __forceinline__ int lds_byte(int r, int c) { const int st = (r >> 4) * 2 + (c >> 5), rr = r & 15, cc = c & 31, ob = rr * 64 + cc * 2; return st * 1024 + (ob ^ (((ob >> 9) & 1) << 5)); }
__host__ __device__ __forceinline__ void stage_rc(int b, int& R, int& C) { const int st = b / 1024, sb = b % 1024, swz = sb ^ (((sb >> 9) & 1) << 5); R = (st >> 1) * 16 + swz / 64; C = (st & 1) * 32 + (swz % 64) / 2; }
__host__ __device__ __forceinline__ int perm32(int rho) { const int n = rho >> 4, i = rho & 15; return 8 * (i >> 2) + 4 * n + (i & 3); }

struct Unit { int pm, pn; };
struct Gemm { const bf16_t* A; const bf16_t* Bt; int M, N, K; };

struct StaticOrder {
    int nM, nN, nwg, G, c;
    __host__ __device__ void init(int M, int N, int G_, int c_) { nM = M / BM; nN = N / BM; nwg = nM * nN; G = G_; c = c_; }
    __host__ __device__ bool next(int i, Unit& u) const {
        const long L = (long)i * G + c; if (L >= nwg) return false;
        int wgid = (int)L; { const int q = nwg / NXCD, r = nwg % NXCD, xcd = wgid % NXCD, off = wgid / NXCD; wgid = (xcd < r ? xcd * (q + 1) : r * (q + 1) + (xcd - r) * q) + off; }
        const int nig = WGM * nN, gid = wgid / nig, fm = gid * WGM, gsz = (nM - fm) < WGM ? (nM - fm) : WGM;
        u.pm = fm + ((wgid % nig) % gsz); u.pn = (wgid % nig) / gsz; return true;
    }
    __device__ __forceinline__ void a_ready(const Unit&) const {}
    __device__ __forceinline__ void done(const Unit&) const {}
};
struct OrderIn {
    int c;
    __host__ __device__ bool next(int i, Unit& u) const { const int x = c & 7, j = c >> 3; u.pm = 4 * x + (j & 3);
        if (i == 0) { u.pn = j >> 2; return true; } if (i == 1 && j < 24) { u.pn = 8 + (j >> 2); return true; } return false; }
    __device__ __forceinline__ void a_ready(const Unit&) const {}
    __device__ __forceinline__ void done(const Unit&) const {}
};
struct OrderTok {
    int c, npn, nrev;
    __host__ __device__ bool next(int i, Unit& u) const { const int x = c & 7, j = c >> 3; u.pm = 4 * x + (j & 3); const int blk = i < nrev ? nrev - 1 - i : i; u.pn = 8 * blk + (j >> 2); return i >= 0 && u.pn < npn; }
    __device__ __forceinline__ void a_ready(const Unit&) const {}
    __device__ __forceinline__ void done(const Unit&) const {}
};
__device__ __forceinline__ unsigned cvt_pk_bf16(float lo, float hi) { unsigned r; asm volatile("v_cvt_pk_bf16_f32 %0, %1, %2" : "=v"(r) : "v"(lo), "v"(hi)); return r; }
typedef float f32x2 __attribute__((ext_vector_type(2)));
__device__ __forceinline__ f32x2 gelu_pk(f32x2 v) {
    const f32x2 av = __builtin_elementwise_abs(v), d = av * 0.2316418882f + 1.0f;
    f32x2 t; t.x = __builtin_amdgcn_rcpf(d.x); t.y = __builtin_amdgcn_rcpf(d.y);
    f32x2 q = t * 0.5307027145f + (-0.7265760135f); q = q * t + 0.7107068705f; q = q * t + (-0.142248368f); q = q * t + 0.127414796f; q = q * t;
    const f32x2 s = (v * v) * (-0.72134752044f);
    f32x2 e; e.x = __builtin_amdgcn_exp2f(s.x); e.y = __builtin_amdgcn_exp2f(s.y);
    const f32x2 m = v * (q * e), r = v - m;
    f32x2 o; o.x = v.x < 0.f ? m.x : r.x; o.y = v.y < 0.f ? m.y : r.y; return o;
}

__device__ __forceinline__ void store16_wt(void* p, u32x4 v) { asm volatile("global_store_dwordx4 %0, %1, off sc1\n\ts_nop 1" :: "v"(p), "v"(v) : "memory"); }
typedef unsigned long long ss_t;
__device__ __forceinline__ void ss_add(ss_t* p, float sq) { const float fl = floorf(sq); const unsigned hi = (unsigned)fl, lo = (unsigned)((sq - fl) * 4294967296.0f); atomicAdd(p, ((ss_t)hi << 32) | (ss_t)lo); }
__device__ __forceinline__ float ss_get(const ss_t* p) { const ss_t v = *p; return (float)(unsigned)(v >> 32) + (float)(unsigned)v * 2.3283064365386963e-10f; }
typedef unsigned u32x2 __attribute__((ext_vector_type(2)));
__device__ __forceinline__ unsigned pkbf(float lo, float hi) { typedef float f2_t __attribute__((ext_vector_type(2))); typedef __bf16 b2_t __attribute__((ext_vector_type(2))); f2_t v = {lo, hi}; b2_t b = __builtin_convertvector(v, b2_t); return __builtin_bit_cast(unsigned, b); }
struct EpiZ {
    static constexpr bool PERM = true, AFTER_DRAIN = false;
    static constexpr bool KSPLIT = false;
    bf16_t* O; int ldc; int gelu_tiles; const ss_t* ssq;
    __device__ __forceinline__ void operator()(const f32x4 (&acc)[2][2][4][2], const Unit& u, int wr, int wc, int fr, int fq) const {
        int row0 = u.pm * BM + wr * 64 + fr; asm volatile("" : "+v"(row0));     const int col0 = u.pn * BM + wc * 32 + 8 * fq; const bool act = u.pn < gelu_tiles;
#pragma unroll
        for (int ai = 0; ai < 2; ++ai)
#pragma unroll
            for (int m = 0; m < 4; ++m) { const int row = row0 + ai * HALF + m * 16; bf16_t* rowp = O + (size_t)row * ldc + col0;
                const float rs = 1.0f / sqrtf(ss_get(ssq + row) * (1.0f / 2048.f) + 1e-6f);
#pragma unroll
                for (int bj = 0; bj < 2; ++bj) { f32x4 v0 = acc[ai][bj][m][0] * rs, v1 = acc[ai][bj][m][1] * rs;
                    if (act) { f32x2 a = gelu_pk((f32x2){v0[0], v0[1]}), b = gelu_pk((f32x2){v0[2], v0[3]}), c = gelu_pk((f32x2){v1[0], v1[1]}), d = gelu_pk((f32x2){v1[2], v1[3]});
                        v0 = (f32x4){a.x, a.y, b.x, b.y}; v1 = (f32x4){c.x, c.y, d.x, d.y}; }
                    u32x4 w; w.x = pkbf(v0[0], v0[1]); w.y = pkbf(v0[2], v0[3]); w.z = pkbf(v1[0], v1[1]); w.w = pkbf(v1[2], v1[3]);
                    *(u32x4*)(rowp + bj * HALF) = w; } }
    }
};
__device__ __forceinline__ f32x2 swiglu_pk(f32x2 g, f32x2 u, float c1, float rs2) {
    const f32x2 z = g * c1; f32x2 e; e.x = __builtin_amdgcn_exp2f(z.x); e.y = __builtin_amdgcn_exp2f(z.y);
    const f32x2 d = e + 1.0f; f32x2 r; r.x = __builtin_amdgcn_rcpf(d.x); r.y = __builtin_amdgcn_rcpf(d.y);
    return (g * u) * (r * rs2);
}
__device__ __forceinline__ float silu_mul(float g, float u) { const float e = __builtin_amdgcn_exp2f(-1.4426950408889634f * g); return g * __builtin_amdgcn_rcpf(1.0f + e) * u; }
struct EpiSwiGLU {
    static constexpr bool PERM = true, AFTER_DRAIN = false;
    static constexpr bool KSPLIT = false;
    bf16_t* O; int ldc; const ss_t* ssq;
    __device__ __forceinline__ void operator()(const f32x4 (&acc)[2][2][4][2], const Unit& u, int wr, int wc, int fr, int fq) const {
        int row0 = u.pm * BM + wr * 64 + fr; asm volatile("" : "+v"(row0));     const int col0 = u.pn * HALF + wc * 32 + 8 * fq;
#pragma unroll
        for (int ai = 0; ai < 2; ++ai)
#pragma unroll
            for (int m = 0; m < 4; ++m) { const int row = row0 + ai * HALF + m * 16; bf16_t* rowp = O + (size_t)row * ldc + col0;
                const float rs = 1.0f / sqrtf(ss_get(ssq + row) * (1.0f / 2048.f) + 1e-6f);
                const float c1 = -1.4426950408889634f * rs, rs2 = rs * rs;
                const f32x4 ga = acc[ai][0][m][0], gb = acc[ai][0][m][1], ua = acc[ai][1][m][0], ub = acc[ai][1][m][1];
                u32x4 w;
                { const f32x2 o = swiglu_pk((f32x2){ga[0], ga[1]}, (f32x2){ua[0], ua[1]}, c1, rs2); w.x = pkbf(o.x, o.y); }
                { const f32x2 o = swiglu_pk((f32x2){ga[2], ga[3]}, (f32x2){ua[2], ua[3]}, c1, rs2); w.y = pkbf(o.x, o.y); }
                { const f32x2 o = swiglu_pk((f32x2){gb[0], gb[1]}, (f32x2){ub[0], ub[1]}, c1, rs2); w.z = pkbf(o.x, o.y); }
                { const f32x2 o = swiglu_pk((f32x2){gb[2], gb[3]}, (f32x2){ub[2], ub[3]}, c1, rs2); w.w = pkbf(o.x, o.y); }
                *(u32x4*)rowp = w; }
    }
};
template <bool KS> struct EpiResid {
    static constexpr bool PERM = true, AFTER_DRAIN = false, KSPLIT = KS;
    float* OUT; int ldc; bf16_t* XB; ss_t* ssq_out; const ss_t* ssa; const ss_t* ssb;
    __device__ __forceinline__ void mid(f32x4 (&acc)[2][2][4][2], const Unit& u, int wr, int wc, int fr, int fq) const {
        int row0 = u.pm * BM + wr * 64 + fr; asm volatile("" : "+v"(row0));
#pragma unroll
        for (int ai = 0; ai < 2; ++ai)
#pragma unroll
            for (int m = 0; m < 4; ++m) { const int row = row0 + ai * HALF + m * 16;
                const float ra = 1.0f / sqrtf(ss_get(ssa + row) * (1.0f / 1024.f) + 1e-6f), rbi = sqrtf(ss_get(ssb + row) * (1.0f / 1024.f) + 1e-6f); const float ratio = ra * rbi;
#pragma unroll
                for (int bj = 0; bj < 2; ++bj)
#pragma unroll
                    for (int n = 0; n < 2; ++n) acc[ai][bj][m][n] = acc[ai][bj][m][n] * ratio; }
    }
    __device__ __forceinline__ void operator()(const f32x4 (&acc)[2][2][4][2], const Unit& u, int wr, int wc, int fr, int fq) const {
        int row0 = u.pm * BM + wr * 64 + fr; asm volatile("" : "+v"(row0));     const int col0 = u.pn * BM + wc * 32 + 8 * fq;
#pragma unroll
        for (int ai = 0; ai < 2; ++ai) {
            u32x4 res[4][2];
#pragma unroll
            for (int m = 0; m < 4; ++m) { const bf16_t* rowp = XB + (size_t)(row0 + ai * HALF + m * 16) * ldc + col0;
#pragma unroll
                for (int bj = 0; bj < 2; ++bj) res[m][bj] = *(const u32x4*)(rowp + bj * HALF); }
            asm volatile("" ::: "memory");
#pragma unroll
            for (int m = 0; m < 4; ++m) { const int row = row0 + ai * HALF + m * 16; const size_t off = (size_t)row * ldc + col0;
                float rs = 1.0f; if (KS) rs = 1.0f / sqrtf(ss_get(ssb + row) * (1.0f / 1024.f) + 1e-6f);
                float sq = 0.f;
#pragma unroll
                for (int bj = 0; bj < 2; ++bj) { const u32x4 r = res[m][bj];
                    const f32x4 x0 = (f32x4){__uint_as_float(r.x << 16), __uint_as_float(r.x & 0xffff0000u), __uint_as_float(r.y << 16), __uint_as_float(r.y & 0xffff0000u)};
                    const f32x4 x1 = (f32x4){__uint_as_float(r.z << 16), __uint_as_float(r.z & 0xffff0000u), __uint_as_float(r.w << 16), __uint_as_float(r.w & 0xffff0000u)};
                    const f32x4 v0 = x0 + acc[ai][bj][m][0] * rs, v1 = x1 + acc[ai][bj][m][1] * rs;
                    if (OUT) { *(f32x4*)(OUT + off + bj * HALF) = v0; *(f32x4*)(OUT + off + bj * HALF + 4) = v1; }
                    else { sq += ((v0[0] * v0[0] + v0[1] * v0[1]) + (v0[2] * v0[2] + v0[3] * v0[3])) + ((v1[0] * v1[0] + v1[1] * v1[1]) + (v1[2] * v1[2] + v1[3] * v1[3]));
                        u32x4 w; w.x = pkbf(v0[0], v0[1]); w.y = pkbf(v0[2], v0[3]); w.z = pkbf(v1[0], v1[1]); w.w = pkbf(v1[2], v1[3]); *(u32x4*)(XB + off + bj * HALF) = w; } }
                if (!OUT) { sq += __shfl_xor(sq, 16); sq += __shfl_xor(sq, 32); if (fq == 0) ss_add(ssq_out + row, sq); } }
            asm volatile("" ::: "memory");
        }
    }
};
template <class Epi, class Sched, bool ALIGN_EPI = false, bool SP2 = false>
__device__ __forceinline__ void gemm_phase(PG8_LAS unsigned char* lds, const Gemm g, const Sched& S, const Epi& E) {
    int tid_l = threadIdx.x; asm volatile("" : "+v"(tid_l));
    const int tid = tid_l, wid = __builtin_amdgcn_readfirstlane(tid >> 6), lane = tid & 63, wr = wid >> 2, wc = wid & 3, fr = lane & 15, fq = lane >> 4;
    const int K = g.K, nt = K / BK;
    unsigned voffA[2], voffB[2];
#pragma unroll
    for (int i = 0; i < 2; ++i) { int R, C; stage_rc(tid * 16 + i * 8192, R, C); const int Rb = Epi::PERM ? ((R & ~31) + perm32(R & 31)) : R;
        voffA[i] = (unsigned)(R * K + C) * 2u; voffB[i] = (unsigned)(Rb * K + C) * 2u; }
    const size_t kstep = (size_t)(BK * 2);
    const size_t hstep = (size_t)HALF * K * 2;
    const size_t tstep = 2 * hstep;
    const unsigned ldsw = (unsigned)wid * 1024u;
    const int aoff = lds_byte(wr * 64 + fr, fq * 8), boff = lds_byte(wc * 32 + fr, fq * 8);
#define PG8_SA(b, h) (((b) * 2 + (h)) * HTB)
#define PG8_SB(b, h) ((4 + (b) * 2 + (h)) * HTB)
#define PG8_STAGE(bufoff, gbase, voff) do { _Pragma("unroll") for (int _i = 0; _i < 2; ++_i) \
        __builtin_amdgcn_global_load_lds((const unsigned*)((const char*)(gbase) + (voff)[_i]), (PG8_LAS unsigned*)(lds + (bufoff) + ldsw + _i * 8192), 16, 0, 0); } while (0)
#define PG8_LDA(dst, b, h) do { _Pragma("unroll") for (int m = 0; m < 4; ++m) _Pragma("unroll") for (int k = 0; k < 2; ++k) dst[m][k] = *(const PG8_LAS bf16x8*)(lds + PG8_SA(b, h) + aoff + m * 2048 + k * 1024); } while (0)
#define PG8_LDB(dst, b, h) do { _Pragma("unroll") for (int n = 0; n < 2; ++n) _Pragma("unroll") for (int k = 0; k < 2; ++k) dst[n][k] = *(const PG8_LAS bf16x8*)(lds + PG8_SB(b, h) + boff + n * 2048 + k * 1024); } while (0)
#define PG8_MMA(ai, bj, At, Bt) do { __builtin_amdgcn_s_setprio(1); _Pragma("unroll") for (int m = 0; m < 4; ++m) _Pragma("unroll") for (int n = 0; n < 2; ++n) _Pragma("unroll") for (int k = 0; k < 2; ++k) \
        acc[ai][bj][m][n] = __builtin_amdgcn_mfma_f32_16x16x32_bf16(Bt[n][k], At[m][k], acc[ai][bj][m][n], 0, 0, 0); __builtin_amdgcn_s_setprio(0); } while (0)
#define PG8_WAIT_V(n) asm volatile("s_waitcnt vmcnt(" #n ")" ::: "memory")
#define PG8_WAIT_L(n) asm volatile("s_waitcnt lgkmcnt(" #n ")" ::: "memory")
#define PG8_BAR __builtin_amdgcn_s_barrier()
#define PG8_SCHED __builtin_amdgcn_sched_barrier(0)
    Unit cur, nxt; int ui = 0;
    if (!S.next(0, cur)) return;
    f32x4 acc[2][2][4][2];
#pragma unroll
    for (int a = 0; a < 2; ++a)
#pragma unroll
        for (int b = 0; b < 2; ++b)
#pragma unroll
            for (int m = 0; m < 4; ++m)
#pragma unroll
                for (int n = 0; n < 2; ++n) acc[a][b][m][n] = (f32x4){0.f, 0.f, 0.f, 0.f};
    bf16x8 At[4][2], B0[2][2], B1[2][2];
    const char* cA = (const char*)g.A + (size_t)cur.pm * tstep; const char* cB = (const char*)g.Bt + (size_t)cur.pn * tstep;
    S.a_ready(cur);
    if constexpr (SP2) {
        PG8_STAGE(PG8_SB(0, 0), cB, voffB); PG8_STAGE(PG8_SB(0, 1), cB + hstep, voffB); PG8_STAGE(PG8_SA(0, 0), cA, voffA); PG8_STAGE(PG8_SA(0, 1), cA + hstep, voffA);
        if (wr == 1) PG8_BAR;
        PG8_WAIT_V(2); PG8_BAR;
        PG8_STAGE(PG8_SB(1, 0), cB + kstep, voffB); PG8_STAGE(PG8_SA(1, 0), cA + kstep, voffA); PG8_STAGE(PG8_SB(1, 1), cB + hstep + kstep, voffB);
        PG8_WAIT_V(6); PG8_BAR;
    } else {
        PG8_STAGE(PG8_SB(0, 0), cB, voffB); PG8_STAGE(PG8_SA(0, 0), cA, voffA); PG8_STAGE(PG8_SB(0, 1), cB + hstep, voffB); PG8_STAGE(PG8_SA(0, 1), cA + hstep, voffA);
        if (wr == 1) PG8_BAR;
        PG8_WAIT_V(4); PG8_BAR;
        PG8_STAGE(PG8_SB(1, 0), cB + kstep, voffB); PG8_STAGE(PG8_SA(1, 0), cA + kstep, voffA); PG8_STAGE(PG8_SB(1, 1), cB + hstep + kstep, voffB);
        PG8_WAIT_V(6); PG8_BAR;
    }
    for (;;) {
        const bool has_next = S.next(ui + 1, nxt);
        const char* nA = has_next ? (const char*)g.A + (size_t)nxt.pm * tstep : cA; const char* nB = has_next ? (const char*)g.Bt + (size_t)nxt.pn * tstep : cB;
        for (int t = 0; t < nt; t += 2) {
            const bool last = (t == nt - 2);
            const char* a1 = cA + (size_t)(t + 1) * kstep;
            const char* a2 = last ? nA : cA + (size_t)(t + 2) * kstep; const char* b2 = last ? nB : cB + (size_t)(t + 2) * kstep;
            const char* a3 = a2 + kstep; const char* b3 = b2 + kstep;
            if (last && has_next) S.a_ready(nxt);
            if constexpr (Epi::KSPLIT) { if (t == (nt >> 1)) E.mid(acc, cur, wr, wc, fr, fq); }
            if constexpr (SP2) {
            PG8_LDB(B0, 0, 0); PG8_LDB(B1, 0, 1); PG8_SCHED; PG8_LDA(At, 0, 0); PG8_STAGE(PG8_SA(1, 1), a1 + hstep, voffA);
            PG8_WAIT_V(8); PG8_WAIT_L(0); PG8_BAR; PG8_MMA(0, 0, At, B0); PG8_MMA(0, 1, At, B1); PG8_BAR; PG8_SCHED;
            PG8_LDA(At, 0, 1); PG8_STAGE(PG8_SB(0, 0), b2, voffB); PG8_STAGE(PG8_SB(0, 1), b2 + hstep, voffB); PG8_STAGE(PG8_SA(0, 0), a2, voffA);
            PG8_WAIT_V(8); PG8_WAIT_L(0); PG8_BAR; PG8_MMA(1, 0, At, B0); PG8_MMA(1, 1, At, B1); PG8_BAR; PG8_SCHED;
            PG8_LDB(B0, 1, 0); PG8_LDB(B1, 1, 1); PG8_SCHED; PG8_LDA(At, 1, 0); PG8_STAGE(PG8_SA(0, 1), a2 + hstep, voffA);
            PG8_WAIT_V(8); PG8_WAIT_L(0); PG8_BAR; PG8_MMA(0, 0, At, B0); PG8_MMA(0, 1, At, B1); PG8_BAR; PG8_SCHED;
            PG8_LDA(At, 1, 1); PG8_STAGE(PG8_SB(1, 0), b3, voffB); PG8_STAGE(PG8_SB(1, 1), b3 + hstep, voffB); PG8_STAGE(PG8_SA(1, 0), a3, voffA);
            PG8_WAIT_V(8); PG8_WAIT_L(0); PG8_BAR; PG8_MMA(1, 0, At, B0); PG8_MMA(1, 1, At, B1); PG8_BAR; PG8_SCHED;
            } else {
            PG8_LDB(B0, 0, 0); PG8_SCHED; PG8_LDA(At, 0, 0); PG8_STAGE(PG8_SA(1, 1), a1 + hstep, voffA);
            PG8_WAIT_L(8); PG8_BAR; PG8_WAIT_L(0); PG8_MMA(0, 0, At, B0); PG8_BAR; PG8_SCHED;
            PG8_LDB(B1, 0, 1); PG8_STAGE(PG8_SB(0, 0), b2, voffB);
            PG8_BAR; PG8_WAIT_L(0); PG8_MMA(0, 1, At, B1); PG8_BAR;
            PG8_LDA(At, 0, 1); PG8_STAGE(PG8_SA(0, 0), a2, voffA);
            PG8_BAR; PG8_WAIT_L(0); PG8_MMA(1, 0, At, B0); PG8_BAR; PG8_SCHED;
            PG8_STAGE(PG8_SB(0, 1), b2 + hstep, voffB);
            PG8_WAIT_V(6); PG8_BAR; PG8_MMA(1, 1, At, B1); PG8_BAR;
            PG8_LDB(B0, 1, 0); PG8_SCHED; PG8_LDA(At, 1, 0); PG8_STAGE(PG8_SA(0, 1), a2 + hstep, voffA);
            PG8_WAIT_L(8); PG8_BAR; PG8_WAIT_L(0); PG8_MMA(0, 0, At, B0); PG8_BAR; PG8_SCHED;
            PG8_LDB(B1, 1, 1); PG8_STAGE(PG8_SB(1, 0), b3, voffB);
            PG8_BAR; PG8_WAIT_L(0); PG8_MMA(0, 1, At, B1); PG8_BAR;
            PG8_LDA(At, 1, 1); PG8_STAGE(PG8_SA(1, 0), a3, voffA);
            PG8_BAR; PG8_WAIT_L(0); PG8_MMA(1, 0, At, B0); PG8_BAR; PG8_SCHED;
            PG8_STAGE(PG8_SB(1, 1), b3 + hstep, voffB);
            PG8_WAIT_V(6); PG8_BAR; PG8_MMA(1, 1, At, B1); PG8_BAR;
            }
        }
        if constexpr (ALIGN_EPI) { if (wr == 0) PG8_BAR; }
        if constexpr (!Epi::AFTER_DRAIN) { E(acc, cur, wr, wc, fr, fq); S.done(cur); }
        if (!has_next) break;
#pragma unroll
        for (int a = 0; a < 2; ++a)
#pragma unroll
            for (int b = 0; b < 2; ++b)
#pragma unroll
                for (int m = 0; m < 4; ++m)
#pragma unroll
                    for (int n = 0; n < 2; ++n) acc[a][b][m][n] = (f32x4){0.f, 0.f, 0.f, 0.f};
        cur = nxt; cA = nA; cB = nB; ++ui;
        if constexpr (ALIGN_EPI) { if (wr == 1) PG8_BAR; }
    }
    PG8_WAIT_V(0);
    if constexpr (!ALIGN_EPI) { if (wr == 0) PG8_BAR; }
    PG8_BAR;
    if constexpr (Epi::AFTER_DRAIN) { E.fused(acc, cur, wr, wc, fr, fq, lds, wid, lane); S.done(cur); }
#undef PG8_SA
#undef PG8_SB
#undef PG8_STAGE
#undef PG8_LDA
#undef PG8_LDB
#undef PG8_MMA
#undef PG8_WAIT_V
#undef PG8_WAIT_L
#undef PG8_BAR
#undef PG8_SCHED
}
}
constexpr int SEQ = 8192, DM = 2048, INW = 3584, DFF = 5632, DEPTH = 4, NGU = 2 * DFF;
constexpr int QCOL = 2048, KCOL = 3072, VCOL = 3328;
constexpr float EPS = 1e-6f;
constexpr size_t MiB = 1u << 20;
constexpr size_t WS_CTL = 0;
constexpr size_t WS_WIN = 2 * MiB,               SZ_WIN = (size_t)INW * DM * 2;
constexpr size_t WS_WOUT = WS_WIN + 4 * SZ_WIN,  SZ_WOUT = (size_t)DM * DM * 2;
constexpr size_t WS_WGU = WS_WOUT + 4 * SZ_WOUT, SZ_WGU = (size_t)NGU * DM * 2;
constexpr size_t WS_WDN = WS_WGU + 4 * SZ_WGU,   SZ_WDN = (size_t)DM * DFF * 2;
constexpr size_t WS_XN = WS_WDN + 4 * SZ_WDN;
constexpr size_t WS_Z = WS_XN + (size_t)SEQ * DM * 2;
constexpr size_t WS_MIX = WS_Z + (size_t)SEQ * INW * 2;
constexpr size_t WS_ACT = WS_MIX + (size_t)SEQ * DM * 2;
constexpr size_t WS_END = WS_ACT + (size_t)SEQ * DFF * 2;
constexpr size_t WS_SS = 65536;
constexpr int SS_Q1 = 0, SS_Q2 = 4, SS_A = 8, SS_B = 12;
constexpr size_t CTL_ZERO_BYTES = WS_SS + 16 * (size_t)SEQ * 8;
constexpr int LDS_BYTES = 147456;
constexpr int NWAVES = 8;

typedef unsigned short bf16;
typedef float f32x4 __attribute__((ext_vector_type(4)));
typedef short bf16x8 __attribute__((ext_vector_type(8)));
typedef unsigned u32x4 __attribute__((ext_vector_type(4)));
typedef unsigned u32x2 __attribute__((ext_vector_type(2)));
using pg8::pkbf; using pg8::ss_t; using pg8::ss_add; using pg8::ss_get;
__device__ __forceinline__ float bflo(unsigned w) { return __uint_as_float(w << 16); }
__device__ __forceinline__ float bfhi(unsigned w) { return __uint_as_float(w & 0xffff0000u); }
__device__ __forceinline__ float wave_sum(float v) {
#pragma unroll
    for (int o = 1; o < 64; o <<= 1) v += __shfl_xor(v, o);
    return v;
}

struct Args {
    const float *x, *rel_bias, *norm1_g, *w_in, *sgu_norm_g, *sgu_w, *sgu_b, *q_norm_g, *k_norm_g, *sinks, *out_norm_a, *out_norm_b, *w_out, *norm2_g, *w_gate, *w_up, *w_down;
    float* out; unsigned char* ws;
    int never, pad;
};

constexpr int TSCR = 64 * 65 * 4;
__device__ __forceinline__ void transpose_item(const float* W, int K, int N, bf16* WT, int k0, int n0, int dst_row0, const float* gain_k0, float* scr, int lane) {
    const int r = lane >> 4, q = lane & 15;
    const float* src = W + (size_t)(k0 + r) * N + n0 + 4 * q;
    f32x4 v[16];
#pragma unroll
    for (int i = 0; i < 16; ++i) v[i] = __builtin_nontemporal_load((const f32x4*)(src + (size_t)(4 * i) * N));
#pragma unroll
    for (int i = 0; i < 16; ++i) { float* d = scr + (4 * i + r) * 65 + 4 * q; d[0] = v[i].x; d[1] = v[i].y; d[2] = v[i].z; d[3] = v[i].w; }
    asm volatile("s_waitcnt lgkmcnt(0)" ::: "memory");
    const int c = lane & 7;
    f32x4 g0 = (f32x4){1.f, 1.f, 1.f, 1.f}, g1 = g0;
    if (gain_k0) { g0 = *(const f32x4*)(gain_k0 + 8 * c); g1 = *(const f32x4*)(gain_k0 + 8 * c + 4); }
#pragma unroll
    for (int j = 0; j < 8; ++j) { const int n = (lane >> 3) + 8 * j; const float* s = scr + (8 * c) * 65 + n;
        u32x4 o; o.x = pkbf(s[0 * 65] * g0.x, s[1 * 65] * g0.y); o.y = pkbf(s[2 * 65] * g0.z, s[3 * 65] * g0.w); o.z = pkbf(s[4 * 65] * g1.x, s[5 * 65] * g1.y); o.w = pkbf(s[6 * 65] * g1.z, s[7 * 65] * g1.w);
        *(u32x4*)(WT + (size_t)(dst_row0 + n) * K + k0 + 8 * c) = o; }
    asm volatile("s_waitcnt lgkmcnt(0)" ::: "memory");
}
__device__ __forceinline__ void prologue_rows(const float* X, bf16* XB, ss_t* ssq, int gw, int NGW, int lane) {
    for (int m = gw; m < SEQ; m += NGW) {
        const f32x4* xr = (const f32x4*)(X + (size_t)m * DM) + lane;
        f32x4 v[8]; float ss = 0.f;
#pragma unroll
        for (int j = 0; j < 8; ++j) { v[j] = xr[64 * j]; ss += (v[j].x * v[j].x + v[j].y * v[j].y) + (v[j].z * v[j].z + v[j].w * v[j].w); }
        ss = wave_sum(ss); if (lane == 0) { const float fl = floorf(ss); ssq[m] = ((ss_t)(unsigned)fl << 32) | (ss_t)(unsigned)((ss - fl) * 4294967296.0f); }
        u32x2* o = (u32x2*)(XB + (size_t)m * DM) + lane;
#pragma unroll
        for (int j = 0; j < 8; ++j) { u32x2 w; w.x = pkbf(v[j].x, v[j].y); w.y = pkbf(v[j].z, v[j].w); o[64 * j] = w; }
    }
}
#define LAS __attribute__((address_space(3)))
#define XB_TMO      128
#define XB_XCNT(j)  (256  + 64 * (j))
#define XB_XSUB(j)  (1280 + 64 * (j))
#define XB_XGEN(j)  (2304 + 64 * (j))
#define XB_TOP      3328
#define XB_TOPGEN   3392
#define XCD_BAR_WORDS 3456
#define XB_SPIN_CAP (1u << 18)

__device__ __forceinline__ unsigned xb_ld(unsigned* p)              { return __hip_atomic_load(p, __ATOMIC_RELAXED, __HIP_MEMORY_SCOPE_AGENT); }
__device__ __forceinline__ unsigned xb_add(unsigned* p, unsigned v) { return __hip_atomic_fetch_add(p, v, __ATOMIC_RELAXED, __HIP_MEMORY_SCOPE_AGENT); }
__device__ __forceinline__ unsigned xb_xcc_id() { return (unsigned)__builtin_amdgcn_s_getreg((3 << 11) | 20) & 0xFu; }
#define XB_SPIN(cond, bar) do { unsigned _sp = 0; while (cond) { __builtin_amdgcn_s_sleep(1); \
    if ((++_sp & 255u) == 0u) { if (xb_ld(&(bar)[XB_TMO])) break; if (_sp > XB_SPIN_CAP) { atomicAdd(&(bar)[XB_TMO], 1u); break; } } } } while (0)

struct XcdBarrier {
    unsigned* bar; unsigned x;
    volatile LAS unsigned* st;
};

__device__ __forceinline__ XcdBarrier xcd_barrier_post(unsigned* bar, volatile LAS unsigned* st) {
    XcdBarrier b; b.bar = bar; b.x = xb_xcc_id(); b.st = st;
    if (threadIdx.x == 0) (void)xb_add(&bar[XB_XCNT(b.x)], 1u);
    return b;
}
__device__ __forceinline__ void xcd_barrier_complete(unsigned* bar, unsigned x, unsigned& nloc, unsigned& nx) {
    const unsigned G = gridDim.x * gridDim.y * gridDim.z;
    unsigned sum, cnt, mine, sp = 0u;
    for (;;) {
        sum = 0u; cnt = 0u; mine = 0u;
#pragma unroll
        for (unsigned j = 0; j < 16; ++j) { const unsigned c = xb_ld(&bar[XB_XCNT(j)]); sum += c; cnt += (c > 0u) ? 1u : 0u; mine = (j == x) ? c : mine; }
        if (sum == G) break;
        __builtin_amdgcn_s_sleep(1);
        if ((++sp & 255u) == 0u) { if (xb_ld(&bar[XB_TMO])) break; if (sp > XB_SPIN_CAP) { atomicAdd(&bar[XB_TMO], 1u); break; } }
    }
    nloc = mine > 0u ? mine : 1u; nx = cnt > 0u ? cnt : 1u;
}

__device__ __forceinline__ void xcd_barrier(const XcdBarrier& b) {
    asm volatile("s_waitcnt vmcnt(0)" ::: "memory");
    __syncthreads();
    if (threadIdx.x == 0) {
        unsigned* bar = b.bar;
        __builtin_amdgcn_s_waitcnt(0);
        unsigned nloc = b.st[0], nx = b.st[1];
        if (nloc == 0u) { xcd_barrier_complete(bar, b.x, nloc, nx); b.st[0] = nloc; b.st[1] = nx; }
        const unsigned old = xb_add(&bar[XB_XSUB(b.x)], 1u);
        const unsigned gen = old / nloc;
        if (old + 1u == (gen + 1u) * nloc) {
            __builtin_amdgcn_fence(__ATOMIC_RELEASE, "agent");
            asm volatile("s_waitcnt vmcnt(0)" ::: "memory");
            const unsigned og = xb_add(&bar[XB_TOP], 1u);
            const unsigned tg = og / nx;
            if (og + 1u == (tg + 1u) * nx) xb_add(&bar[XB_TOPGEN], 1u);
            else XB_SPIN(xb_ld(&bar[XB_TOPGEN]) == tg, bar);
            __builtin_amdgcn_fence(__ATOMIC_ACQUIRE, "agent");
            xb_add(&bar[XB_XGEN(b.x)], 1u);
            asm volatile("s_waitcnt vmcnt(0)" ::: "memory");
        } else {
            XB_SPIN(xb_ld(&bar[XB_XGEN(b.x)]) == gen, bar);
            __builtin_amdgcn_fence(__ATOMIC_ACQUIRE, "agent");
            asm volatile("s_waitcnt vmcnt(0)" ::: "memory");
        }
    }
    __syncthreads();
}

#define LB_SUB(j) (4096 + 64 * (j))
#define LB_GEN(j) (5120 + 64 * (j))
__device__ __forceinline__ void xcc_local_barrier(unsigned* bar, unsigned x, unsigned nloc) {
    asm volatile("s_waitcnt vmcnt(0)" ::: "memory");
    __syncthreads();
    if (threadIdx.x == 0) {
        __builtin_amdgcn_s_waitcnt(0);
        const unsigned old = xb_add(&bar[LB_SUB(x)], 1u);
        const unsigned gen = old / nloc;
        if (old + 1u == (gen + 1u) * nloc) xb_add(&bar[LB_GEN(x)], 1u);
        else XB_SPIN(xb_ld(&bar[LB_GEN(x)]) == gen, bar);
        __builtin_amdgcn_fence(__ATOMIC_ACQUIRE, "agent");
        asm volatile("s_waitcnt vmcnt(0)" ::: "memory");
    }
    __syncthreads();
}
constexpr int KS_STRIDE = 72;
constexpr int VT_STRIDE = 264;
constexpr int LDS_KS = 0, LDS_VT = 256 * KS_STRIDE * 2, LDS_BT = LDS_VT + 64 * VT_STRIDE * 2;
constexpr int VN_STRIDE = 136;
#define MFMA16(a, b, c) __builtin_amdgcn_mfma_f32_16x16x32_bf16((a), (b), (c), 0, 0, 0)

__device__ __forceinline__ int t5_bucket(int n) {
    if (n < 16) return n;
    const float v = logf((float)n / 16.0f) / 2.0794415416798357f * 16.0f;
    int b = 16 + (int)v; return b < 31 ? b : 31;
}

__device__ __forceinline__ void attn_load_q(u32x4 (&q0)[2], const bf16* Z, int n, int kvh, int wid, int lane) {
    const int g = wid >> 1, qh = wid & 1, hq = kvh * 4 + g, fr = lane & 15, fq = lane >> 4;
    const bf16* qp = Z + (size_t)(n * 128 + 64 * qh + fr) * INW + QCOL + hq * 64; q0[0] = *(const u32x4*)(qp + 8 * fq); q0[1] = *(const u32x4*)(qp + 32 + 8 * fq);
}
template <int PAR> __device__ __forceinline__ void attn_sub(const bf16* KS, const bf16* VT, const float* BTg, const float* gq, float sink2, int n, int ti, int hq, const u32x4 w0, const u32x4 w1, bf16* MIX, ss_t* ssb, int lane) {
    const int fr = lane & 15, fq = lane >> 4; const int qi = 16 * ti + fr, tb = ti - PAR; const int tok = n * 128 + qi;
    bf16x8 qf[2];
    { float f0[8], f1[8]; float ss = 0.f;
#pragma unroll
      for (int e = 0; e < 4; ++e) { f0[2 * e] = bflo(w0[e]); f0[2 * e + 1] = bfhi(w0[e]); f1[2 * e] = bflo(w1[e]); f1[2 * e + 1] = bfhi(w1[e]);
          ss += (f0[2 * e] * f0[2 * e] + f0[2 * e + 1] * f0[2 * e + 1]) + (f1[2 * e] * f1[2 * e] + f1[2 * e + 1] * f1[2 * e + 1]); }
      ss += __shfl_xor(ss, 16); ss += __shfl_xor(ss, 32);
      const float rs = (0.125f * 1.4426950408889634f) / sqrtf(ss * (1.0f / 64.f) + EPS);
      const f32x4 a0 = *(const f32x4*)(gq + 8 * fq), a1 = *(const f32x4*)(gq + 8 * fq + 4), b0 = *(const f32x4*)(gq + 32 + 8 * fq), b1 = *(const f32x4*)(gq + 32 + 8 * fq + 4);
      u32x4 p0, p1;
      p0.x = pkbf(f0[0] * rs * a0.x, f0[1] * rs * a0.y); p0.y = pkbf(f0[2] * rs * a0.z, f0[3] * rs * a0.w); p0.z = pkbf(f0[4] * rs * a1.x, f0[5] * rs * a1.y); p0.w = pkbf(f0[6] * rs * a1.z, f0[7] * rs * a1.w);
      p1.x = pkbf(f1[0] * rs * b0.x, f1[1] * rs * b0.y); p1.y = pkbf(f1[2] * rs * b0.z, f1[3] * rs * b0.w); p1.z = pkbf(f1[4] * rs * b1.x, f1[5] * rs * b1.y); p1.w = pkbf(f1[6] * rs * b1.z, f1[7] * rs * b1.w);
      qf[0] = __builtin_bit_cast(bf16x8, p0); qf[1] = __builtin_bit_cast(bf16x8, p1); }
    const int e0 = 4 * fq - fr;
    const float* bp = BTg + (128 - 16 * 8 - 3 - e0);
    f32x4 sc[10]; float mx = sink2;
#pragma unroll
    for (int t = 0; t < 10; ++t) {
        constexpr int dummy = 0; (void)dummy;
        const int rel = t - PAR;
        if (rel < 0 || rel > 8) { sc[t] = (f32x4){0.f, 0.f, 0.f, 0.f}; continue; }
        const bf16* kp = KS + (16 * (tb + t) + fr) * KS_STRIDE + 8 * fq;
        const bf16x8 k0 = *(const bf16x8*)kp, k1 = *(const bf16x8*)(kp + 32);
        f32x4 acc = (f32x4){0.f, 0.f, 0.f, 0.f};
        acc = MFMA16(k0, qf[0], acc); acc = MFMA16(k1, qf[1], acc);
        const bool tv = (n > 0) || (tb + t >= 8);
#pragma unroll
        for (int r = 0; r < 4; ++r) { bool valid = tv; if (rel == 0) valid = valid && (e0 + r >= 1); if (rel == 8) valid = valid && (e0 + r <= 0);
            const float v = valid ? acc[r] + bp[16 * (8 - rel) + (3 - r)] : -1e30f; acc[r] = v; mx = fmaxf(mx, v); }
        sc[t] = acc;
    }
    mx = fmaxf(mx, __shfl_xor(mx, 16)); mx = fmaxf(mx, __shfl_xor(mx, 32));
    float lsum = 0.f;
#pragma unroll
    for (int t = 0; t < 10; ++t) { const int rel = t - PAR; if (rel < 0 || rel > 8) continue;
#pragma unroll
        for (int r = 0; r < 4; ++r) { const float p = __builtin_amdgcn_exp2f(sc[t][r] - mx); sc[t][r] = p; lsum += p; } }
    lsum += __shfl_xor(lsum, 16); lsum += __shfl_xor(lsum, 32);
    lsum += __builtin_amdgcn_exp2f(sink2 - mx);
    const float rl = 1.0f / lsum;
    f32x4 o[4];
#pragma unroll
    for (int dt = 0; dt < 4; ++dt) o[dt] = (f32x4){0.f, 0.f, 0.f, 0.f};
#pragma unroll
    for (int p = 0; p < 5; ++p) {
        u32x4 pw; pw.x = pkbf(sc[2 * p][0], sc[2 * p][1]); pw.y = pkbf(sc[2 * p][2], sc[2 * p][3]); pw.z = pkbf(sc[2 * p + 1][0], sc[2 * p + 1][1]); pw.w = pkbf(sc[2 * p + 1][2], sc[2 * p + 1][3]);
        const bf16x8 pb = __builtin_bit_cast(bf16x8, pw);
#pragma unroll
        for (int dt = 0; dt < 4; ++dt) {
            const bf16* vp = VT + (16 * dt + fr) * VT_STRIDE + 16 * (tb + 2 * p) + 4 * fq;
            const u32x2 lo = *(const u32x2*)vp, hi = *(const u32x2*)(vp + 16);
            const u32x4 va = (u32x4){lo.x, lo.y, hi.x, hi.y};
            o[dt] = MFMA16(__builtin_bit_cast(bf16x8, va), pb, o[dt]);
        }
    }
    bf16* op = MIX + (size_t)tok * DM + 1024 + hq * 64 + 4 * fq;
    float sq = 0.f;
#pragma unroll
    for (int dt = 0; dt < 4; ++dt) { const f32x4 v = o[dt] * rl; sq += (v[0] * v[0] + v[1] * v[1]) + (v[2] * v[2] + v[3] * v[3]); u32x2 w; w.x = pkbf(v[0], v[1]); w.y = pkbf(v[2], v[3]); *(u32x2*)(op + 16 * dt) = w; }
    sq += __shfl_xor(sq, 16); sq += __shfl_xor(sq, 32); if (fq == 0) ss_add(ssb + tok, sq);
}
__device__ __forceinline__ void attn_compute(const Args& A, int l, int n, int kvh, const u32x4 (&q0)[2], const bf16* Z, bf16* MIX, ss_t* ssb, unsigned char* lds, int wid, int lane) {
    const bf16* KS = (const bf16*)(lds + LDS_KS); const bf16* VT = (const bf16*)(lds + LDS_VT); const float* BT = (const float*)(lds + LDS_BT);
    const float* gq = A.q_norm_g + l * 64;
    const int g = wid >> 1, qh = wid & 1, hq = kvh * 4 + g; const int fr = lane & 15, fq = lane >> 4;
    const float sink2 = A.sinks[l * 16 + hq] * 1.4426950408889634f;
    const float* BTg = BT + g * 128;
    u32x4 qc0 = q0[0], qc1 = q0[1];
#pragma nounroll
    for (int ip = 0; ip < 2; ++ip) {
        const int ti = 4 * qh + 2 * ip;
        const bf16* qp = Z + (size_t)(n * 128 + 16 * ti + fr) * INW + QCOL + hq * 64;
        u32x4 w0 = qc0, w1 = qc1;
        qc0 = *(const u32x4*)(qp + (size_t)16 * INW + 8 * fq); qc1 = *(const u32x4*)(qp + (size_t)16 * INW + 32 + 8 * fq);
        attn_sub<0>(KS, VT, BTg, gq, sink2, n, ti, hq, w0, w1, MIX, ssb, lane);
        w0 = qc0; w1 = qc1;
        if (ip == 0) { qc0 = *(const u32x4*)(qp + (size_t)32 * INW + 8 * fq); qc1 = *(const u32x4*)(qp + (size_t)32 * INW + 32 + 8 * fq); }
        attn_sub<1>(KS, VT, BTg, gq, sink2, n, ti + 1, hq, w0, w1, MIX, ssb, lane);
    }
}

__device__ __forceinline__ void attn_unit(const Args& A, int l, int n, int kvh, const bf16* Z, bf16* MIX, ss_t* ssb, unsigned char* lds, int tid, int wid, int lane) {
    bf16* KS = (bf16*)(lds + LDS_KS); bf16* VT = (bf16*)(lds + LDS_VT); float* BT = (float*)(lds + LDS_BT);
    const float* gk = A.k_norm_g + l * 64; const float* gq = A.q_norm_g + l * 64;
#pragma unroll
    for (int i = 0; i < 4; ++i) {
        const int id = tid + 512 * i, row = id >> 3, ch = id & 7; const int tok = (n - 1) * 128 + row;
        u32x4 kw = (u32x4){0u, 0u, 0u, 0u}, vw = (u32x4){0u, 0u, 0u, 0u};
        if (tok >= 0) { const bf16* zr = Z + (size_t)tok * INW; kw = *(const u32x4*)(zr + KCOL + kvh * 64 + ch * 8); vw = *(const u32x4*)(zr + VCOL + kvh * 64 + ch * 8); }
        float f[8]; float ss = 0.f;
#pragma unroll
        for (int e = 0; e < 4; ++e) { f[2 * e] = bflo(kw[e]); f[2 * e + 1] = bfhi(kw[e]); ss += f[2 * e] * f[2 * e] + f[2 * e + 1] * f[2 * e + 1]; }
        ss += __shfl_xor(ss, 1); ss += __shfl_xor(ss, 2); ss += __shfl_xor(ss, 4);
        const float rstd = 1.0f / sqrtf(ss * (1.0f / 64.f) + EPS);
        const f32x4 g0 = *(const f32x4*)(gk + ch * 8), g1 = *(const f32x4*)(gk + ch * 8 + 4);
        u32x4 o; o.x = pkbf(f[0] * rstd * g0.x, f[1] * rstd * g0.y); o.y = pkbf(f[2] * rstd * g0.z, f[3] * rstd * g0.w); o.z = pkbf(f[4] * rstd * g1.x, f[5] * rstd * g1.y); o.w = pkbf(f[6] * rstd * g1.z, f[7] * rstd * g1.w);
        *(u32x4*)(KS + row * KS_STRIDE + ch * 8) = o;
#pragma unroll
        for (int e = 0; e < 4; ++e) { VT[(ch * 8 + 2 * e) * VT_STRIDE + row] = (bf16)(vw[e] & 0xffffu); VT[(ch * 8 + 2 * e + 1) * VT_STRIDE + row] = (bf16)(vw[e] >> 16); }
    }
    { const int g = tid >> 7, dist = tid & 127; BT[g * 128 + dist] = A.rel_bias[t5_bucket(dist) * 16 + kvh * 4 + g] * 1.4426950408889634f; }
    __syncthreads();
    { u32x4 q0[2]; attn_load_q(q0, Z, n, kvh, wid, lane); attn_compute(A, l, n, kvh, q0, Z, MIX, ssb, lds, wid, lane); }
    __syncthreads();
}

__device__ __forceinline__ void sgu_unit(const Args& A, int l, int c, int h, const bf16* Z, bf16* MIX, ss_t* ssa, unsigned char* lds, int tid, int wid, int lane) {
    bf16* VN = (bf16*)lds;
    const float* gs = A.sgu_norm_g + (l * 16 + h) * 64;
#pragma unroll
    for (int i = 0; i < 2; ++i) {
        const int id = tid + 512 * i, row = id >> 3, ch = id & 7;
        const u32x4 vw = *(const u32x4*)(Z + (size_t)(c * 128 + row) * INW + 1024 + h * 64 + ch * 8);
        float f[8]; float ss = 0.f;
#pragma unroll
        for (int e = 0; e < 4; ++e) { f[2 * e] = bflo(vw[e]); f[2 * e + 1] = bfhi(vw[e]); ss += f[2 * e] * f[2 * e] + f[2 * e + 1] * f[2 * e + 1]; }
        ss += __shfl_xor(ss, 1); ss += __shfl_xor(ss, 2); ss += __shfl_xor(ss, 4);
        const float rstd = 1.0f / sqrtf(ss * (1.0f / 64.f) + EPS);
#pragma unroll
        for (int e = 0; e < 8; e += 2) { const unsigned w = pkbf(f[e] * rstd * gs[ch * 8 + e], f[e + 1] * rstd * gs[ch * 8 + e + 1]);
            VN[(ch * 8 + e) * VN_STRIDE + row] = (bf16)(w & 0xffffu); VN[(ch * 8 + e + 1) * VN_STRIDE + row] = (bf16)(w >> 16); }
    }
    __syncthreads();
    const int fr = lane & 15, fq = lane >> 4; const int t = 16 * wid + fr; const int nks = (wid >> 1) + 1;
    const float* wrow = A.sgu_w + ((size_t)(l * 16 + h) * 128 + t) * 128;
    bf16x8 bfr[4];
#pragma unroll
    for (int ks = 0; ks < 4; ++ks) {
        u32x4 w = (u32x4){0u, 0u, 0u, 0u};
        if (ks < nks) { const int s0 = 32 * ks + 8 * fq; const f32x4 a = *(const f32x4*)(wrow + s0), b = *(const f32x4*)(wrow + s0 + 4);
            float f[8] = {a.x, a.y, a.z, a.w, b.x, b.y, b.z, b.w};
#pragma unroll
            for (int e = 0; e < 8; ++e) f[e] = (s0 + e <= t) ? f[e] : 0.f;
            w.x = pkbf(f[0], f[1]); w.y = pkbf(f[2], f[3]); w.z = pkbf(f[4], f[5]); w.w = pkbf(f[6], f[7]); }
        bfr[ks] = __builtin_bit_cast(bf16x8, w);
    }
    const float bias = A.sgu_b[(l * 16 + h) * 128 + t];
    const size_t tok = (size_t)(c * 128 + t); float sq = 0.f;
#pragma unroll
    for (int dt = 0; dt < 4; ++dt) {
        f32x4 acc = (f32x4){0.f, 0.f, 0.f, 0.f};
#pragma unroll
        for (int ks = 0; ks < 4; ++ks) if (ks < nks) { const bf16x8 a = *(const bf16x8*)(VN + (16 * dt + fr) * VN_STRIDE + 32 * ks + 8 * fq); acc = MFMA16(a, bfr[ks], acc); }
        const int d0 = h * 64 + 16 * dt + 4 * fq;
        const u32x2 uw = *(const u32x2*)(Z + tok * INW + d0);
        const float v0 = bflo(uw.x) * (acc[0] + bias), v1 = bfhi(uw.x) * (acc[1] + bias), v2 = bflo(uw.y) * (acc[2] + bias), v3 = bfhi(uw.y) * (acc[3] + bias);
        sq += (v0 * v0 + v1 * v1) + (v2 * v2 + v3 * v3);
        u32x2 w; w.x = pkbf(v0, v1); w.y = pkbf(v2, v3);
        *(u32x2*)(MIX + tok * DM + d0) = w;
    }
    sq += __shfl_xor(sq, 16); sq += __shfl_xor(sq, 32); if (fq == 0) ss_add(ssa + tok, sq);
    __syncthreads();
}
constexpr int LDS_VN0 = LDS_BT + 2048;
static_assert(LDS_VN0 + 4 * 64 * VN_STRIDE * 2 <= LDS_BYTES - 16, "mixer LDS map");
__device__ __forceinline__ void mixer_phase256(const Args& A, int l, int vc, const bf16* Z, bf16* MIX, ss_t* ssa, ss_t* ssb, unsigned char* lds, int tid, int wid, int lane) {
    bf16* KS = (bf16*)(lds + LDS_KS); bf16* VT = (bf16*)(lds + LDS_VT); float* BT = (float*)(lds + LDS_BT); bf16* VN = (bf16*)(lds + LDS_VN0);
    const int gx = vc & 7, gj = vc >> 3;
    const int n = 8 * gx + (gj >> 2), kvh = gj & 3, h = gj & 15, cb = 8 * gx + 4 * (gj >> 4);
    const int fr = lane & 15, fq = lane >> 4;
    const bool isK = tid < 256; const int arow = tid & 255; const int atok = (n - 1) * 128 + arow;
    u32x4 aw[8], sw[8];
    { const bf16* ap = Z + (size_t)(atok < 0 ? 0 : atok) * INW + (isK ? KCOL : VCOL) + kvh * 64;
#pragma unroll
      for (int c = 0; c < 8; ++c) aw[c] = *(const u32x4*)(ap + 8 * c); }
    const int srow = tid & 127, sj = tid >> 7;
    { const bf16* sp = Z + (size_t)((cb + sj) * 128 + srow) * INW + 1024 + h * 64;
#pragma unroll
      for (int c = 0; c < 8; ++c) sw[c] = *(const u32x4*)(sp + 8 * c); }
    const int st = 16 * wid + fr; const int nks = (wid >> 1) + 1;
    const float* wrow = A.sgu_w + ((size_t)(l * 16 + h) * 128 + st) * 128;
    f32x4 wa[4][2];
#pragma unroll
    for (int ks = 0; ks < 4; ++ks) { wa[ks][0] = (f32x4){0.f, 0.f, 0.f, 0.f}; wa[ks][1] = wa[ks][0];
        if (ks < nks) { wa[ks][0] = *(const f32x4*)(wrow + 32 * ks + 8 * fq); wa[ks][1] = *(const f32x4*)(wrow + 32 * ks + 8 * fq + 4); } }
    const float sbias = A.sgu_b[(l * 16 + h) * 128 + st];
    { const int g = tid >> 7, dist = tid & 127; BT[g * 128 + dist] = A.rel_bias[t5_bucket(dist) * 16 + kvh * 4 + g] * 1.4426950408889634f; }
    if (atok < 0) {
#pragma unroll
        for (int c = 0; c < 8; ++c) aw[c] = (u32x4){0u, 0u, 0u, 0u}; }
    if (isK) {
        const float* gk = A.k_norm_g + l * 64; float ss = 0.f;
#pragma unroll
        for (int c = 0; c < 8; ++c)
#pragma unroll
            for (int e = 0; e < 4; ++e) { const float a = bflo(aw[c][e]), b = bfhi(aw[c][e]); ss += a * a + b * b; }
        const float rstd = 1.0f / sqrtf(ss * (1.0f / 64.f) + EPS);
#pragma unroll
        for (int c = 0; c < 8; ++c) { const f32x4 g0 = *(const f32x4*)(gk + 8 * c), g1 = *(const f32x4*)(gk + 8 * c + 4); u32x4 o;
            o.x = pkbf(bflo(aw[c].x) * rstd * g0.x, bfhi(aw[c].x) * rstd * g0.y); o.y = pkbf(bflo(aw[c].y) * rstd * g0.z, bfhi(aw[c].y) * rstd * g0.w);
            o.z = pkbf(bflo(aw[c].z) * rstd * g1.x, bfhi(aw[c].z) * rstd * g1.y); o.w = pkbf(bflo(aw[c].w) * rstd * g1.z, bfhi(aw[c].w) * rstd * g1.w);
            *(u32x4*)(KS + arow * KS_STRIDE + 8 * c) = o; }
    } else {
#pragma unroll
        for (int c = 0; c < 8; ++c)
#pragma unroll
            for (int e = 0; e < 4; ++e) { VT[(8 * c + 2 * e) * VT_STRIDE + arow] = (bf16)(aw[c][e] & 0xffffu); VT[(8 * c + 2 * e + 1) * VT_STRIDE + arow] = (bf16)(aw[c][e] >> 16); }
    }
    { const float* gs = A.sgu_norm_g + (l * 16 + h) * 64; float ss = 0.f; bf16* vn = VN + sj * 64 * VN_STRIDE;
#pragma unroll
      for (int c = 0; c < 8; ++c)
#pragma unroll
          for (int e = 0; e < 4; ++e) { const float a = bflo(sw[c][e]), b = bfhi(sw[c][e]); ss += a * a + b * b; }
      const float rstd = 1.0f / sqrtf(ss * (1.0f / 64.f) + EPS);
#pragma unroll
      for (int c = 0; c < 8; ++c) { const f32x4 g0 = *(const f32x4*)(gs + 8 * c), g1 = *(const f32x4*)(gs + 8 * c + 4); const float gg[8] = {g0.x, g0.y, g0.z, g0.w, g1.x, g1.y, g1.z, g1.w};
#pragma unroll
          for (int e = 0; e < 4; ++e) { const unsigned w = pkbf(bflo(sw[c][e]) * rstd * gg[2 * e], bfhi(sw[c][e]) * rstd * gg[2 * e + 1]);
              vn[(8 * c + 2 * e) * VN_STRIDE + srow] = (bf16)(w & 0xffffu); vn[(8 * c + 2 * e + 1) * VN_STRIDE + srow] = (bf16)(w >> 16); } }
    }
    asm volatile("" ::: "memory");
    u32x4 q0[2]; attn_load_q(q0, Z, n, kvh, wid, lane);
    u32x2 uw[4][4];
#pragma unroll
    for (int j = 0; j < 4; ++j)
#pragma unroll
        for (int dt = 0; dt < 4; ++dt) uw[j][dt] = *(const u32x2*)(Z + (size_t)((cb + j) * 128 + st) * INW + h * 64 + 16 * dt + 4 * fq);
    __syncthreads();
    {
        bf16x8 bfr[4];
#pragma unroll
        for (int ks = 0; ks < 4; ++ks) { float f[8] = {wa[ks][0].x, wa[ks][0].y, wa[ks][0].z, wa[ks][0].w, wa[ks][1].x, wa[ks][1].y, wa[ks][1].z, wa[ks][1].w}; const int s0 = 32 * ks + 8 * fq;
#pragma unroll
            for (int e = 0; e < 8; ++e) f[e] = (s0 + e <= st) ? f[e] : 0.f;
            u32x4 w; w.x = pkbf(f[0], f[1]); w.y = pkbf(f[2], f[3]); w.z = pkbf(f[4], f[5]); w.w = pkbf(f[6], f[7]); bfr[ks] = __builtin_bit_cast(bf16x8, w); }
#pragma unroll
        for (int j = 0; j < 4; ++j) {
            const bf16* vn = VN + j * 64 * VN_STRIDE; const size_t tok = (size_t)((cb + j) * 128 + st); float sq = 0.f;
#pragma unroll
            for (int dt = 0; dt < 4; ++dt) {
                f32x4 acc = (f32x4){0.f, 0.f, 0.f, 0.f};
#pragma unroll
                for (int ks = 0; ks < 4; ++ks) if (ks < nks) { const bf16x8 a = *(const bf16x8*)(vn + (16 * dt + fr) * VN_STRIDE + 32 * ks + 8 * fq); acc = MFMA16(a, bfr[ks], acc); }
                const float v0 = bflo(uw[j][dt].x) * (acc[0] + sbias), v1 = bfhi(uw[j][dt].x) * (acc[1] + sbias), v2 = bflo(uw[j][dt].y) * (acc[2] + sbias), v3 = bfhi(uw[j][dt].y) * (acc[3] + sbias);
                sq += (v0 * v0 + v1 * v1) + (v2 * v2 + v3 * v3);
                u32x2 w; w.x = pkbf(v0, v1); w.y = pkbf(v2, v3);
                *(u32x2*)(MIX + tok * DM + h * 64 + 16 * dt + 4 * fq) = w;
            }
            sq += __shfl_xor(sq, 16); sq += __shfl_xor(sq, 32); if (fq == 0) ss_add(ssa + tok, sq);
        }
    }
    attn_compute(A, l, n, kvh, q0, Z, MIX, ssb, lds, wid, lane);
}
constexpr int I_IN = (DM / 64) * (INW / 64), I_OUT = (DM / 64) * (DM / 64), I_G = (DM / 64) * (DFF / 64), I_DN = (DFF / 64) * (DM / 64);
constexpr int PER_LAYER = I_IN + I_OUT + 2 * I_G + I_DN;
constexpr int Q_P = 5500, Q_G1 = 3000, Q_G3 = 8500, N_ALL = DEPTH * PER_LAYER;
constexpr bool queue_ok() {
    for (int l = 0; l < DEPTH; ++l) {
        const long c1 = Q_P + (long)l * (Q_G1 + Q_G3) + Q_G1, c3 = Q_P + (long)(l + 1) * (Q_G1 + Q_G3);
        const long r1 = (long)l * PER_LAYER + I_IN + I_OUT + 2 * I_G, r3 = (long)(l + 1) * PER_LAYER + (l + 1 < DEPTH ? I_IN : 0);
        if (c1 < r1 || c3 < r3) return false;
    }
    return Q_P >= I_IN;
}
static_assert(queue_ok(), "conversion queue deadlines");
__device__ __forceinline__ void convert_items(const Args& A, unsigned char* ws, int g0, int g1, int w, int nw, float* scr, int lane) {
    for (int it = g0 + w; it < g1; it += nw) {
        const int l = it / PER_LAYER; int r = it % PER_LAYER;
        if (r < I_IN) { const int nb = INW / 64, kb = r / nb, n0 = 64 * (r % nb); transpose_item(A.w_in + (size_t)l * DM * INW, DM, INW, (bf16*)(ws + WS_WIN + l * SZ_WIN), 64 * kb, n0, n0, A.norm1_g + l * DM + 64 * kb, scr, lane); continue; } r -= I_IN;
        if (r < I_OUT) { const int nb = DM / 64, kb = r / nb, n0 = 64 * (r % nb); transpose_item(A.w_out + (size_t)l * DM * DM, DM, DM, (bf16*)(ws + WS_WOUT + l * SZ_WOUT), 64 * kb, n0, n0, (kb < 16 ? A.out_norm_a + l * 1024 + 64 * kb : A.out_norm_b + l * 1024 + 64 * (kb - 16)), scr, lane); continue; } r -= I_OUT;
        if (r < I_G) { const int nb = DFF / 64, kb = r / nb, n0 = 64 * (r % nb); transpose_item(A.w_gate + (size_t)l * DM * DFF, DM, DFF, (bf16*)(ws + WS_WGU + l * SZ_WGU), 64 * kb, n0, 256 * (n0 / 128) + (n0 % 128), A.norm2_g + l * DM + 64 * kb, scr, lane); continue; } r -= I_G;
        if (r < I_G) { const int nb = DFF / 64, kb = r / nb, n0 = 64 * (r % nb); transpose_item(A.w_up + (size_t)l * DM * DFF, DM, DFF, (bf16*)(ws + WS_WGU + l * SZ_WGU), 64 * kb, n0, 256 * (n0 / 128) + 128 + (n0 % 128), A.norm2_g + l * DM + 64 * kb, scr, lane); continue; } r -= I_G;
        { const int nb = DM / 64, kb = r / nb, n0 = 64 * (r % nb); transpose_item(A.w_down + (size_t)l * DFF * DM, DFF, DM, (bf16*)(ws + WS_WDN + l * SZ_WDN), 64 * kb, n0, n0, nullptr, scr, lane); }
    }
}

__global__ void __launch_bounds__(NWAVES * 64, 2) fwd_kernel(Args A) {
    extern __shared__ __attribute__((aligned(16))) unsigned char lds[];
    cg::grid_group grid = cg::this_grid();
    const int G = gridDim.x, bx = blockIdx.x, NGW = G * NWAVES;
#define PHASE_IDS() int tid = threadIdx.x; asm volatile("" : "+v"(tid)); const int lane = tid & 63, wid = __builtin_amdgcn_readfirstlane(tid >> 6), gw = bx * NWAVES + wid; (void)lane; (void)gw
    unsigned char* ws = A.ws;
    bf16* XB = (bf16*)(ws + WS_XN); ss_t* SS = (ss_t*)(ws + WS_SS); bf16* Z = (bf16*)(ws + WS_Z); bf16* MIX = (bf16*)(ws + WS_MIX); bf16* ACT = (bf16*)(ws + WS_ACT);
    float* X = A.out;
    PG8_LAS unsigned char* ldsl = (PG8_LAS unsigned char*)lds;
    volatile LAS unsigned* bst = (volatile LAS unsigned*)(ldsl + LDS_BYTES - 16);
    if (threadIdx.x < 4) bst[threadIdx.x] = 0u;
    __syncthreads();
    unsigned* barw = (unsigned*)(ws + WS_CTL);
    XcdBarrier bar; bar.bar = barw; bar.st = bst; bar.x = xb_xcc_id();
    if (threadIdx.x == 0) bst[2] = xb_add(&barw[XB_XCNT(bar.x)], 1u);
    __syncthreads();
    const unsigned my_x = bar.x, my_r = (unsigned)__builtin_amdgcn_readfirstlane((int)bst[2]);
#define GRID_BAR() xcd_barrier(bar)

    {
        PHASE_IDS();
        float* scr = (float*)(lds + wid * TSCR);
        const bool lazy = (G == 256);
        convert_items(A, ws, 0, lazy ? Q_P : N_ALL, gw, NGW, scr, lane);
        prologue_rows(A.x, XB, SS + (size_t)SS_Q1 * SEQ, gw, NGW, lane);
    }
    if (A.never) grid.sync();
    GRID_BAR();
    bool tp = (G == 256);
    if (tp) { for (unsigned q = 0; q < 16; ++q) { const unsigned c = xb_ld(&barw[XB_XCNT(q)]); tp = tp && (c == (q < 8 ? 32u : 0u)); } }
    tp = __builtin_amdgcn_readfirstlane((int)tp) != 0;
    const int vc = tp ? (int)(my_r * 8u + my_x) : bx;
#define LOCAL_BAR() do { if (tp) xcc_local_barrier(barw, my_x, 32u); else xcd_barrier(bar); } while (0)

#pragma nounroll
    for (int l = 0; l < DEPTH; ++l) {
        { pg8::Gemm g{XB, (const bf16*)(ws + WS_WIN + l * SZ_WIN), SEQ, INW, DM};
          pg8::EpiZ E{Z, INW, 8, SS + (size_t)(SS_Q1 + l) * SEQ};
          if (G == 256) { pg8::OrderTok S{vc, INW / 256, 0}; pg8::gemm_phase<pg8::EpiZ, pg8::OrderTok, false, true>(ldsl, g, S, E); }
          else { pg8::StaticOrder S; S.init(SEQ, INW, G, bx); pg8::gemm_phase<pg8::EpiZ, pg8::StaticOrder, true, true>(ldsl, g, S, E); } }
        if (G == 256 && vc >= 192) {
            PHASE_IDS(); const int g0 = Q_P + l * (Q_G1 + Q_G3), g1 = g0 + Q_G1;
            convert_items(A, ws, g0 < N_ALL ? g0 : N_ALL, g1 < N_ALL ? g1 : N_ALL, (vc - 192) * NWAVES + wid, 64 * NWAVES, (float*)(lds + wid * TSCR), lane); }
        GRID_BAR();
        { PHASE_IDS();
          if (G == 256) mixer_phase256(A, l, vc, Z, MIX, SS + (size_t)(SS_A + l) * SEQ, SS + (size_t)(SS_B + l) * SEQ, lds, tid, wid, lane);
          else {
            for (int a = bx; a < 256; a += G) attn_unit(A, l, a >> 2, a & 3, Z, MIX, SS + (size_t)(SS_B + l) * SEQ, lds, tid, wid, lane);
            for (int s = bx; s < 1024; s += G) sgu_unit(A, l, s >> 4, s & 15, Z, MIX, SS + (size_t)(SS_A + l) * SEQ, lds, tid, wid, lane); } }
        LOCAL_BAR();
        { pg8::Gemm g{MIX, (const bf16*)(ws + WS_WOUT + l * SZ_WOUT), SEQ, DM, DM};
          pg8::EpiResid<true> E{nullptr, DM, XB, SS + (size_t)(SS_Q2 + l) * SEQ, SS + (size_t)(SS_A + l) * SEQ, SS + (size_t)(SS_B + l) * SEQ};
          if (G == 256) { pg8::OrderTok S{vc, DM / 256, 0}; pg8::gemm_phase<pg8::EpiResid<true>, pg8::OrderTok, false, true>(ldsl, g, S, E); }
          else { pg8::StaticOrder S; S.init(SEQ, DM, G, bx); pg8::gemm_phase<pg8::EpiResid<true>, pg8::StaticOrder, true, true>(ldsl, g, S, E); } }
        LOCAL_BAR();
        { pg8::Gemm g{XB, (const bf16*)(ws + WS_WGU + l * SZ_WGU), SEQ, NGU, DM};
          pg8::EpiSwiGLU E{ACT, DFF, SS + (size_t)(SS_Q2 + l) * SEQ};
          if (G == 256) { pg8::OrderTok S{vc, NGU / 256, 5}; pg8::gemm_phase<pg8::EpiSwiGLU, pg8::OrderTok, false, true>(ldsl, g, S, E); }
          else { pg8::StaticOrder S; S.init(SEQ, NGU, G, bx); pg8::gemm_phase<pg8::EpiSwiGLU, pg8::StaticOrder, true, true>(ldsl, g, S, E); } }
        if (G == 256 && vc >= 128) {
            PHASE_IDS(); const int g0 = Q_P + l * (Q_G1 + Q_G3) + Q_G1, g1 = g0 + Q_G3;
            convert_items(A, ws, g0 < N_ALL ? g0 : N_ALL, g1 < N_ALL ? g1 : N_ALL, (vc - 128) * NWAVES + wid, 128 * NWAVES, (float*)(lds + wid * TSCR), lane); }
        GRID_BAR();
        { pg8::Gemm g{ACT, (const bf16*)(ws + WS_WDN + l * SZ_WDN), SEQ, DM, DFF};
          const bool more = l + 1 < DEPTH;
          pg8::EpiResid<false> E{more ? nullptr : X, DM, XB, SS + (size_t)(SS_Q1 + (more ? l + 1 : 0)) * SEQ, nullptr, nullptr};
          if (G == 256) { pg8::OrderTok S{vc, DM / 256, 0}; pg8::gemm_phase<pg8::EpiResid<false>, pg8::OrderTok, false, true>(ldsl, g, S, E); }
          else { pg8::StaticOrder S; S.init(SEQ, DM, G, bx); pg8::gemm_phase<pg8::EpiResid<false>, pg8::StaticOrder, true, true>(ldsl, g, S, E); } }
        if (l + 1 < DEPTH) LOCAL_BAR();
    }
}

extern "C" void kernel_launch(void* const* d_in, const int* in_sizes, int n_in, void* d_out, int out_size, void* d_ws, size_t ws_size, hipStream_t stream) {
    static int grid = 0;
    if (grid == 0) {
        if (n_in != 17 || out_size != SEQ * DM || ws_size < WS_END) { fprintf(stderr, "kernel_launch: unexpected shapes n_in %d out %d ws %zu (need %zu)\n", n_in, out_size, ws_size, (size_t)WS_END); grid = -1; return; }
        int dev = 0, cus = 0, per_cu = 0;
        (void)hipGetDevice(&dev); (void)hipDeviceGetAttribute(&cus, hipDeviceAttributeMultiprocessorCount, dev);
        (void)hipFuncSetAttribute((const void*)fwd_kernel, hipFuncAttributeMaxDynamicSharedMemorySize, LDS_BYTES);
        (void)hipOccupancyMaxActiveBlocksPerMultiprocessor(&per_cu, (const void*)fwd_kernel, NWAVES * 64, LDS_BYTES);
        if (per_cu < 1) { fprintf(stderr, "kernel_launch: occupancy query says %d blocks per CU\n", per_cu); per_cu = 1; }
        grid = cus * per_cu;
        fprintf(stderr, "kernel_launch: grid %d (cus %d x %d), ws %zu need %zu\n", grid, cus, per_cu, ws_size, (size_t)WS_END);
    }
    if (grid < 0) return;
    Args a{};
    a.x = (const float*)d_in[0]; a.rel_bias = (const float*)d_in[1]; a.norm1_g = (const float*)d_in[2]; a.w_in = (const float*)d_in[3]; a.sgu_norm_g = (const float*)d_in[4];
    a.sgu_w = (const float*)d_in[5]; a.sgu_b = (const float*)d_in[6]; a.q_norm_g = (const float*)d_in[7]; a.k_norm_g = (const float*)d_in[8]; a.sinks = (const float*)d_in[9];
    a.out_norm_a = (const float*)d_in[10]; a.out_norm_b = (const float*)d_in[11]; a.w_out = (const float*)d_in[12]; a.norm2_g = (const float*)d_in[13];
    a.w_gate = (const float*)d_in[14]; a.w_up = (const float*)d_in[15]; a.w_down = (const float*)d_in[16];
    a.out = (float*)d_out; a.ws = (unsigned char*)d_ws;
    (void)hipMemsetAsync((char*)d_ws + WS_CTL, 0, CTL_ZERO_BYTES, stream);
    void* args[] = {&a};
    hipError_t e = hipLaunchCooperativeKernel((const void*)fwd_kernel, dim3(grid), dim3(NWAVES * 64), args, LDS_BYTES, stream);
    if (e != hipSuccess) fprintf(stderr, "kernel_launch: cooperative launch failed: %s (grid %d)\n", hipGetErrorString(e), grid);
}
```

```cpp
#include <hip/hip_runtime.h>
#include <hip/hip_cooperative_groups.h>
#include <cstdio>
#include <cstdint>
namespace cg = cooperative_groups;
namespace pg8 {
#define PG8_LAS __attribute__((address_space(3)))
typedef unsigned short bf16_t;
typedef short bf16x8 __attribute__((ext_vector_type(8)));
typedef float f32x4 __attribute__((ext_vector_type(4)));
typedef unsigned u32x4 __attribute__((ext_vector_type(4)));
constexpr int BM = 256, BK = 64, HALF = 128, HTB = HALF * BK * 2  , STAGE_BYTES = 8 * HTB, NXCD = 8, WGM = 8;

__host__ __device__ __forceinline__ int lds_byte(int r, int c) { const int st = (r >> 4) * 2 + (c >> 5), rr = r & 15, cc = c & 31, ob = rr * 64 + cc * 2; return st * 1024 + (ob ^ (((ob >> 9) & 1) << 5)); }
__host__ __device__ __forceinline__ void stage_rc(int b, int& R, int& C) { const int st = b / 1024, sb = b % 1024, swz = sb ^ (((sb >> 9) & 1) << 5); R = (st >> 1) * 16 + swz / 64; C = (st & 1) * 32 + (swz % 64) / 2; }
__host__ __device__ __forceinline__ int perm32(int rho) { const int n = rho >> 4, i = rho & 15; return 8 * (i >> 2) + 4 * n + (i & 3); }

struct Unit { int pm, pn; };
struct Gemm { const bf16_t* A; const bf16_t* Bt; int M, N, K; };

struct StaticOrder {
    int nM, nN, nwg, G, c;
    __host__ __device__ void init(int M, int N, int G_, int c_) { nM = M / BM; nN = N / BM; nwg = nM * nN; G = G_; c = c_; }
    __host__ __device__ bool next(int i, Unit& u) const {
        const long L = (long)i * G + c; if (L >= nwg) return false;
        int wgid = (int)L; { const int q = nwg / NXCD, r = nwg % NXCD, xcd = wgid % NXCD, off = wgid / NXCD; wgid = (xcd < r ? xcd * (q + 1) : r * (q + 1) + (xcd - r) * q) + off; }
        const int nig = WGM * nN, gid = wgid / nig, fm = gid * WGM, gsz = (nM - fm) < WGM ? (nM - fm) : WGM;
        u.pm = fm + ((wgid % nig) % gsz); u.pn = (wgid % nig) / gsz; return true;
    }
    __device__ __forceinline__ void a_ready(const Unit&) const {}
    __device__ __forceinline__ void done(const Unit&) const {}
};
struct OrderIn {
    int c;
    __host__ __device__ bool next(int i, Unit& u) const { const int x = c & 7, j = c >> 3; u.pm = 4 * x + (j & 3);
        if (i == 0) { u.pn = j >> 2; return true; } if (i == 1 && j < 24) { u.pn = 8 + (j >> 2); return true; } return false; }
    __device__ __forceinline__ void a_ready(const Unit&) const {}
    __device__ __forceinline__ void done(const Unit&) const {}
};
struct OrderTok {
    int c, npn, nrev;
    __host__ __device__ bool next(int i, Unit& u) const { const int x = c & 7, j = c >> 3; u.pm = 4 * x + (j & 3); const int blk = i < nrev ? nrev - 1 - i : i; u.pn = 8 * blk + (j >> 2); return i >= 0 && u.pn < npn; }
    __device__ __forceinline__ void a_ready(const Unit&) const {}
    __device__ __forceinline__ void done(const Unit&) const {}
};
__device__ __forceinline__ unsigned cvt_pk_bf16(float lo, float hi) { unsigned r; asm volatile("v_cvt_pk_bf16_f32 %0, %1, %2" : "=v"(r) : "v"(lo), "v"(hi)); return r; }
typedef float f32x2 __attribute__((ext_vector_type(2)));
__device__ __forceinline__ f32x2 gelu_pk(f32x2 v) {
    const f32x2 av = __builtin_elementwise_abs(v), d = av * 0.2316418882f + 1.0f;
    f32x2 t; t.x = __builtin_amdgcn_rcpf(d.x); t.y = __builtin_amdgcn_rcpf(d.y);
    f32x2 q = t * 0.5307027145f + (-0.7265760135f); q = q * t + 0.7107068705f; q = q * t + (-0.142248368f); q = q * t + 0.127414796f; q = q * t;
    const f32x2 s = (v * v) * (-0.72134752044f);
    f32x2 e; e.x = __builtin_amdgcn_exp2f(s.x); e.y = __builtin_amdgcn_exp2f(s.y);
    const f32x2 m = v * (q * e), r = v - m;
    f32x2 o; o.x = v.x < 0.f ? m.x : r.x; o.y = v.y < 0.f ? m.y : r.y; return o;
}

__device__ __forceinline__ void store16_wt(void* p, u32x4 v) { asm volatile("global_store_dwordx4 %0, %1, off sc1\n\ts_nop 1" :: "v"(p), "v"(v) : "memory"); }
typedef unsigned long long ss_t;
__device__ __forceinline__ void ss_add(ss_t* p, float sq) { const float fl = floorf(sq); const unsigned hi = (unsigned)fl, lo = (unsigned)((sq - fl) * 4294967296.0f); atomicAdd(p, ((ss_t)hi << 32) | (ss_t)lo); }
__device__ __forceinline__ float ss_get(const ss_t* p) { const ss_t v = *p; return (float)(unsigned)(v >> 32) + (float)(unsigned)v * 2.3283064365386963e-10f; }
typedef unsigned u32x2 __attribute__((ext_vector_type(2)));
__device__ __forceinline__ unsigned pkbf(float lo, float hi) { typedef float f2_t __attribute__((ext_vector_type(2))); typedef __bf16 b2_t __attribute__((ext_vector_type(2))); f2_t v = {lo, hi}; b2_t b = __builtin_convertvector(v, b2_t); return __builtin_bit_cast(unsigned, b); }
struct EpiZ {
    static constexpr bool PERM = true, AFTER_DRAIN = false;
    static constexpr bool KSPLIT = false;
    bf16_t* O; int ldc; int gelu_tiles; const ss_t* ssq;
    __device__ __forceinline__ void operator()(const f32x4 (&acc)[2][2][4][2], const Unit& u, int wr, int wc, int fr, int fq) const {
        int row0 = u.pm * BM + wr * 64 + fr; asm volatile("" : "+v"(row0));     const int col0 = u.pn * BM + wc * 32 + 8 * fq; const bool act = u.pn < gelu_tiles; const bool xw = ((u.pm & 3) == 3) && (u.pn >= 12);
#pragma unroll
        for (int ai = 0; ai < 2; ++ai)
#pragma unroll
            for (int m = 0; m < 4; ++m) { const int row = row0 + ai * HALF + m * 16; bf16_t* rowp = O + (size_t)row * ldc + col0;
                const float rs = 1.0f / sqrtf(ss_get(ssq + row) * (1.0f / 2048.f) + 1e-6f);
#pragma unroll
                for (int bj = 0; bj < 2; ++bj) { f32x4 v0 = acc[ai][bj][m][0] * rs, v1 = acc[ai][bj][m][1] * rs;
                    if (act) { f32x2 a = gelu_pk((f32x2){v0[0], v0[1]}), b = gelu_pk((f32x2){v0[2], v0[3]}), c = gelu_pk((f32x2){v1[0], v1[1]}), d = gelu_pk((f32x2){v1[2], v1[3]});
                        v0 = (f32x4){a.x, a.y, b.x, b.y}; v1 = (f32x4){c.x, c.y, d.x, d.y}; }
                    u32x4 w; w.x = pkbf(v0[0], v0[1]); w.y = pkbf(v0[2], v0[3]); w.z = pkbf(v1[0], v1[1]); w.w = pkbf(v1[2], v1[3]);
                    if (xw) store16_wt(rowp + bj * HALF, w); else *(u32x4*)(rowp + bj * HALF) = w; } }
    }
};
__device__ __forceinline__ f32x2 swiglu_pk(f32x2 g, f32x2 u, float c1, float rs2) {
    const f32x2 z = g * c1; f32x2 e; e.x = __builtin_amdgcn_exp2f(z.x); e.y = __builtin_amdgcn_exp2f(z.y);
    const f32x2 d = e + 1.0f; f32x2 r; r.x = __builtin_amdgcn_rcpf(d.x); r.y = __builtin_amdgcn_rcpf(d.y);
    return (g * u) * (r * rs2);
}
__device__ __forceinline__ float silu_mul(float g, float u) { const float e = __builtin_amdgcn_exp2f(-1.4426950408889634f * g); return g * __builtin_amdgcn_rcpf(1.0f + e) * u; }
struct EpiSwiGLU {
    static constexpr bool PERM = true, AFTER_DRAIN = false;
    static constexpr bool KSPLIT = false;
    bf16_t* O; int ldc; const ss_t* ssq;
    __device__ __forceinline__ void operator()(const f32x4 (&acc)[2][2][4][2], const Unit& u, int wr, int wc, int fr, int fq) const {
        int row0 = u.pm * BM + wr * 64 + fr; asm volatile("" : "+v"(row0));     const int col0 = u.pn * HALF + wc * 32 + 8 * fq;
#pragma unroll
        for (int ai = 0; ai < 2; ++ai)
#pragma unroll
            for (int m = 0; m < 4; ++m) { const int row = row0 + ai * HALF + m * 16; bf16_t* rowp = O + (size_t)row * ldc + col0;
                const float rs = 1.0f / sqrtf(ss_get(ssq + row) * (1.0f / 2048.f) + 1e-6f);
                const float c1 = -1.4426950408889634f * rs, rs2 = rs * rs;
                const f32x4 ga = acc[ai][0][m][0], gb = acc[ai][0][m][1], ua = acc[ai][1][m][0], ub = acc[ai][1][m][1];
                u32x4 w;
                { const f32x2 o = swiglu_pk((f32x2){ga[0], ga[1]}, (f32x2){ua[0], ua[1]}, c1, rs2); w.x = pkbf(o.x, o.y); }
                { const f32x2 o = swiglu_pk((f32x2){ga[2], ga[3]}, (f32x2){ua[2], ua[3]}, c1, rs2); w.y = pkbf(o.x, o.y); }
                { const f32x2 o = swiglu_pk((f32x2){gb[0], gb[1]}, (f32x2){ub[0], ub[1]}, c1, rs2); w.z = pkbf(o.x, o.y); }
                { const f32x2 o = swiglu_pk((f32x2){gb[2], gb[3]}, (f32x2){ub[2], ub[3]}, c1, rs2); w.w = pkbf(o.x, o.y); }
                *(u32x4*)rowp = w; }
    }
};
template <bool KS> struct EpiResid {
    static constexpr bool PERM = true, AFTER_DRAIN = false, KSPLIT = KS;
    float* OUT; int ldc; bf16_t* XB; ss_t* ssq_out; const ss_t* ssa; const ss_t* ssb;
    __device__ __forceinline__ void mid(f32x4 (&acc)[2][2][4][2], const Unit& u, int wr, int wc, int fr, int fq) const {
        int row0 = u.pm * BM + wr * 64 + fr; asm volatile("" : "+v"(row0));
#pragma unroll
        for (int ai = 0; ai < 2; ++ai)
#pragma unroll
            for (int m = 0; m < 4; ++m) { const int row = row0 + ai * HALF + m * 16;
                const float ra = 1.0f / sqrtf(ss_get(ssa + row) * (1.0f / 1024.f) + 1e-6f), rbi = sqrtf(ss_get(ssb + row) * (1.0f / 1024.f) + 1e-6f); const float ratio = ra * rbi;
#pragma unroll
                for (int bj = 0; bj < 2; ++bj)
#pragma unroll
                    for (int n = 0; n < 2; ++n) acc[ai][bj][m][n] = acc[ai][bj][m][n] * ratio; }
    }
    __device__ __forceinline__ void operator()(const f32x4 (&acc)[2][2][4][2], const Unit& u, int wr, int wc, int fr, int fq) const {
        int row0 = u.pm * BM + wr * 64 + fr; asm volatile("" : "+v"(row0));     const int col0 = u.pn * BM + wc * 32 + 8 * fq;
#pragma unroll
        for (int ai = 0; ai < 2; ++ai) {
            u32x4 res[4][2];
#pragma unroll
            for (int m = 0; m < 4; ++m) { const bf16_t* rowp = XB + (size_t)(row0 + ai * HALF + m * 16) * ldc + col0;
#pragma unroll
                for (int bj = 0; bj < 2; ++bj) res[m][bj] = *(const u32x4*)(rowp + bj * HALF); }
            asm volatile("" ::: "memory");
#pragma unroll
            for (int m = 0; m < 4; ++m) { const int row = row0 + ai * HALF + m * 16; const size_t off = (size_t)row * ldc + col0;
                float rs = 1.0f; if (KS) rs = 1.0f / sqrtf(ss_get(ssb + row) * (1.0f / 1024.f) + 1e-6f);
                float sq = 0.f;
#pragma unroll
                for (int bj = 0; bj < 2; ++bj) { const u32x4 r = res[m][bj];
                    const f32x4 x0 = (f32x4){__uint_as_float(r.x << 16), __uint_as_float(r.x & 0xffff0000u), __uint_as_float(r.y << 16), __uint_as_float(r.y & 0xffff0000u)};
                    const f32x4 x1 = (f32x4){__uint_as_float(r.z << 16), __uint_as_float(r.z & 0xffff0000u), __uint_as_float(r.w << 16), __uint_as_float(r.w & 0xffff0000u)};
                    const f32x4 v0 = x0 + acc[ai][bj][m][0] * rs, v1 = x1 + acc[ai][bj][m][1] * rs;
                    if (OUT) { *(f32x4*)(OUT + off + bj * HALF) = v0; *(f32x4*)(OUT + off + bj * HALF + 4) = v1; }
                    else { sq += ((v0[0] * v0[0] + v0[1] * v0[1]) + (v0[2] * v0[2] + v0[3] * v0[3])) + ((v1[0] * v1[0] + v1[1] * v1[1]) + (v1[2] * v1[2] + v1[3] * v1[3]));
                        u32x4 w; w.x = pkbf(v0[0], v0[1]); w.y = pkbf(v0[2], v0[3]); w.z = pkbf(v1[0], v1[1]); w.w = pkbf(v1[2], v1[3]); *(u32x4*)(XB + off + bj * HALF) = w; } }
                if (!OUT) { sq += __shfl_xor(sq, 16); sq += __shfl_xor(sq, 32); if (fq == 0) ss_add(ssq_out + row, sq); } }
            asm volatile("" ::: "memory");
        }
    }
};
template <class Epi, class Sched, bool ALIGN_EPI = false, bool SP2 = false>
__device__ __forceinline__ void gemm_phase(PG8_LAS unsigned char* lds, const Gemm g, const Sched& S, const Epi& E) {
    int tid_l = threadIdx.x; asm volatile("" : "+v"(tid_l));
    const int tid = tid_l, wid = __builtin_amdgcn_readfirstlane(tid >> 6), lane = tid & 63, wr = wid >> 2, wc = wid & 3, fr = lane & 15, fq = lane >> 4;
    const int K = g.K, nt = K / BK;
    unsigned voffA[2], voffB[2];
#pragma unroll
    for (int i = 0; i < 2; ++i) { int R, C; stage_rc(tid * 16 + i * 8192, R, C); const int Rb = Epi::PERM ? ((R & ~31) + perm32(R & 31)) : R;
        voffA[i] = (unsigned)(R * K + C) * 2u; voffB[i] = (unsigned)(Rb * K + C) * 2u; }
    const size_t kstep = (size_t)(BK * 2);
    const size_t hstep = (size_t)HALF * K * 2;
    const size_t tstep = 2 * hstep;
    const unsigned ldsw = (unsigned)wid * 1024u;
    const int aoff = lds_byte(wr * 64 + fr, fq * 8), boff = lds_byte(wc * 32 + fr, fq * 8);
#define PG8_SA(b, h) (((b) * 2 + (h)) * HTB)
#define PG8_SB(b, h) ((4 + (b) * 2 + (h)) * HTB)
#define PG8_STAGE(bufoff, gbase, voff) do { _Pragma("unroll") for (int _i = 0; _i < 2; ++_i) \
        __builtin_amdgcn_global_load_lds((const unsigned*)((const char*)(gbase) + (voff)[_i]), (PG8_LAS unsigned*)(lds + (bufoff) + ldsw + _i * 8192), 16, 0, 0); } while (0)
#define PG8_LDA(dst, b, h) do { _Pragma("unroll") for (int m = 0; m < 4; ++m) _Pragma("unroll") for (int k = 0; k < 2; ++k) dst[m][k] = *(const PG8_LAS bf16x8*)(lds + PG8_SA(b, h) + aoff + m * 2048 + k * 1024); } while (0)
#define PG8_LDB(dst, b, h) do { _Pragma("unroll") for (int n = 0; n < 2; ++n) _Pragma("unroll") for (int k = 0; k < 2; ++k) dst[n][k] = *(const PG8_LAS bf16x8*)(lds + PG8_SB(b, h) + boff + n * 2048 + k * 1024); } while (0)
#define PG8_MMA(ai, bj, At, Bt) do { __builtin_amdgcn_s_setprio(1); _Pragma("unroll") for (int m = 0; m < 4; ++m) _Pragma("unroll") for (int n = 0; n < 2; ++n) _Pragma("unroll") for (int k = 0; k < 2; ++k) \
        acc[ai][bj][m][n] = __builtin_amdgcn_mfma_f32_16x16x32_bf16(Bt[n][k], At[m][k], acc[ai][bj][m][n], 0, 0, 0); __builtin_amdgcn_s_setprio(0); } while (0)
#define PG8_WAIT_V(n) asm volatile("s_waitcnt vmcnt(" #n ")" ::: "memory")
#define PG8_WAIT_L(n) asm volatile("s_waitcnt lgkmcnt(" #n ")" ::: "memory")
#define PG8_BAR __builtin_amdgcn_s_barrier()
#define PG8_SCHED __builtin_amdgcn_sched_barrier(0)
    Unit cur, nxt; int ui = 0;
    if (!S.next(0, cur)) return;
    f32x4 acc[2][2][4][2];
#pragma unroll
    for (int a = 0; a < 2; ++a)
#pragma unroll
        for (int b = 0; b < 2; ++b)
#pragma unroll
            for (int m = 0; m < 4; ++m)
#pragma unroll
                for (int n = 0; n < 2; ++n) acc[a][b][m][n] = (f32x4){0.f, 0.f, 0.f, 0.f};
    bf16x8 At[4][2], B0[2][2], B1[2][2];
    const char* cA = (const char*)g.A + (size_t)cur.pm * tstep; const char* cB = (const char*)g.Bt + (size_t)cur.pn * tstep;
    S.a_ready(cur);
    if constexpr (SP2) {
        PG8_STAGE(PG8_SB(0, 0), cB, voffB); PG8_STAGE(PG8_SB(0, 1), cB + hstep, voffB); PG8_STAGE(PG8_SA(0, 0), cA, voffA); PG8_STAGE(PG8_SA(0, 1), cA + hstep, voffA);
        if (wr == 1) PG8_BAR;
        PG8_WAIT_V(2); PG8_BAR;
        PG8_STAGE(PG8_SB(1, 0), cB + kstep, voffB); PG8_STAGE(PG8_SA(1, 0), cA + kstep, voffA); PG8_STAGE(PG8_SB(1, 1), cB + hstep + kstep, voffB);
        PG8_WAIT_V(6); PG8_BAR;
    } else {
        PG8_STAGE(PG8_SB(0, 0), cB, voffB); PG8_STAGE(PG8_SA(0, 0), cA, voffA); PG8_STAGE(PG8_SB(0, 1), cB + hstep, voffB); PG8_STAGE(PG8_SA(0, 1), cA + hstep, voffA);
        if (wr == 1) PG8_BAR;
        PG8_WAIT_V(4); PG8_BAR;
        PG8_STAGE(PG8_SB(1, 0), cB + kstep, voffB); PG8_STAGE(PG8_SA(1, 0), cA + kstep, voffA); PG8_STAGE(PG8_SB(1, 1), cB + hstep + kstep, voffB);
        PG8_WAIT_V(6); PG8_BAR;
    }
    for (;;) {
        const bool has_next = S.next(ui + 1, nxt);
        const char* nA = has_next ? (const char*)g.A + (size_t)nxt.pm * tstep : cA; const char* nB = has_next ? (const char*)g.Bt + (size_t)nxt.pn * tstep : cB;
        for (int t = 0; t < nt; t += 2) {
            const bool last = (t == nt - 2);
            const char* a1 = cA + (size_t)(t + 1) * kstep;
            const char* a2 = last ? nA : cA + (size_t)(t + 2) * kstep; const char* b2 = last ? nB : cB + (size_t)(t + 2) * kstep;
            const char* a3 = a2 + kstep; const char* b3 = b2 + kstep;
            if (last && has_next) S.a_ready(nxt);
            if constexpr (Epi::KSPLIT) { if (t == (nt >> 1)) E.mid(acc, cur, wr, wc, fr, fq); }
            if constexpr (SP2) {
            PG8_LDB(B0, 0, 0); PG8_LDB(B1, 0, 1); PG8_SCHED; PG8_LDA(At, 0, 0); PG8_STAGE(PG8_SA(1, 1), a1 + hstep, voffA);
            PG8_WAIT_V(8); PG8_WAIT_L(0); PG8_BAR; PG8_MMA(0, 0, At, B0); PG8_MMA(0, 1, At, B1); PG8_BAR; PG8_SCHED;
            PG8_LDA(At, 0, 1); PG8_STAGE(PG8_SB(0, 0), b2, voffB); PG8_STAGE(PG8_SB(0, 1), b2 + hstep, voffB); PG8_STAGE(PG8_SA(0, 0), a2, voffA);
            PG8_WAIT_V(8); PG8_WAIT_L(0); PG8_BAR; PG8_MMA(1, 0, At, B0); PG8_MMA(1, 1, At, B1); PG8_BAR; PG8_SCHED;
            PG8_LDB(B0, 1, 0); PG8_LDB(B1, 1, 1); PG8_SCHED; PG8_LDA(At, 1, 0); PG8_STAGE(PG8_SA(0, 1), a2 + hstep, voffA);
            PG8_WAIT_V(8); PG8_WAIT_L(0); PG8_BAR; PG8_MMA(0, 0, At, B0); PG8_MMA(0, 1, At, B1); PG8_BAR; PG8_SCHED;
            PG8_LDA(At, 1, 1); PG8_STAGE(PG8_SB(1, 0), b3, voffB); PG8_STAGE(PG8_SB(1, 1), b3 + hstep, voffB); PG8_STAGE(PG8_SA(1, 0), a3, voffA);
            PG8_WAIT_V(8); PG8_WAIT_L(0); PG8_BAR; PG8_MMA(1, 0, At, B0); PG8_MMA(1, 1, At, B1); PG8_BAR; PG8_SCHED;
            } else {
            PG8_LDB(B0, 0, 0); PG8_SCHED; PG8_LDA(At, 0, 0); PG8_STAGE(PG8_SA(1, 1), a1 + hstep, voffA);
            PG8_WAIT_L(8); PG8_BAR; PG8_WAIT_L(0); PG8_MMA(0, 0, At, B0); PG8_BAR; PG8_SCHED;
            PG8_LDB(B1, 0, 1); PG8_STAGE(PG8_SB(0, 0), b2, voffB);
            PG8_BAR; PG8_WAIT_L(0); PG8_MMA(0, 1, At, B1); PG8_BAR;
            PG8_LDA(At, 0, 1); PG8_STAGE(PG8_SA(0, 0), a2, voffA);
            PG8_BAR; PG8_WAIT_L(0); PG8_MMA(1, 0, At, B0); PG8_BAR; PG8_SCHED;
            PG8_STAGE(PG8_SB(0, 1), b2 + hstep, voffB);
            PG8_WAIT_V(6); PG8_BAR; PG8_MMA(1, 1, At, B1); PG8_BAR;
            PG8_LDB(B0, 1, 0); PG8_SCHED; PG8_LDA(At, 1, 0); PG8_STAGE(PG8_SA(0, 1), a2 + hstep, voffA);
            PG8_WAIT_L(8); PG8_BAR; PG8_WAIT_L(0); PG8_MMA(0, 0, At, B0); PG8_BAR; PG8_SCHED;
            PG8_LDB(B1, 1, 1); PG8_STAGE(PG8_SB(1, 0), b3, voffB);
            PG8_BAR; PG8_WAIT_L(0); PG8_MMA(0, 1, At, B1); PG8_BAR;
            PG8_LDA(At, 1, 1); PG8_STAGE(PG8_SA(1, 0), a3, voffA);
            PG8_BAR; PG8_WAIT_L(0); PG8_MMA(1, 0, At, B0); PG8_BAR; PG8_SCHED;
            PG8_STAGE(PG8_SB(1, 1), b3 + hstep, voffB);
            PG8_WAIT_V(6); PG8_BAR; PG8_MMA(1, 1, At, B1); PG8_BAR;
            }
        }
        if constexpr (ALIGN_EPI) { if (wr == 0) PG8_BAR; }
        if constexpr (!Epi::AFTER_DRAIN) { E(acc, cur, wr, wc, fr, fq); S.done(cur); }
        if (!has_next) break;
#pragma unroll
        for (int a = 0; a < 2; ++a)
#pragma unroll
            for (int b = 0; b < 2; ++b)
#pragma unroll
                for (int m = 0; m < 4; ++m)
#pragma unroll
                    for (int n = 0; n < 2; ++n) acc[a][b][m][n] = (f32x4){0.f, 0.f, 0.f, 0.f};
        cur = nxt; cA = nA; cB = nB; ++ui;
        if constexpr (ALIGN_EPI) { if (wr == 1) PG8_BAR; }
    }
    PG8_WAIT_V(0);
    if constexpr (!ALIGN_EPI) { if (wr == 0) PG8_BAR; }
    PG8_BAR;
    if constexpr (Epi::AFTER_DRAIN) { E.fused(acc, cur, wr, wc, fr, fq, lds, wid, lane); S.done(cur); }
#undef PG8_SA
#undef PG8_SB
#undef PG8_STAGE
#undef PG8_LDA
#undef PG8_LDB
#undef PG8_MMA
#undef PG8_WAIT_V
#undef PG8_WAIT_L
#undef PG8_BAR
#undef PG8_SCHED
}
}
constexpr int SEQ = 8192, DM = 2048, INW = 3584, DFF = 5632, DEPTH = 4, NGU = 2 * DFF;
constexpr int QCOL = 2048, KCOL = 3072, VCOL = 3328;
constexpr float EPS = 1e-6f;
constexpr size_t MiB = 1u << 20;
constexpr size_t WS_CTL = 0;
constexpr size_t WS_WIN = 2 * MiB,               SZ_WIN = (size_t)INW * DM * 2;
constexpr size_t WS_WOUT = WS_WIN + 4 * SZ_WIN,  SZ_WOUT = (size_t)DM * DM * 2;
constexpr size_t WS_WGU = WS_WOUT + 4 * SZ_WOUT, SZ_WGU = (size_t)NGU * DM * 2;
constexpr size_t WS_WDN = WS_WGU + 4 * SZ_WGU,   SZ_WDN = (size_t)DM * DFF * 2;
constexpr size_t WS_XN = WS_WDN + 4 * SZ_WDN;
constexpr size_t WS_Z = WS_XN + (size_t)SEQ * DM * 2;
constexpr size_t WS_MIX = WS_Z + (size_t)SEQ * INW * 2;
constexpr size_t WS_ACT = WS_MIX + (size_t)SEQ * DM * 2;
constexpr size_t WS_END = WS_ACT + (size_t)SEQ * DFF * 2;
constexpr size_t WS_SS = 65536;
constexpr int SS_Q1 = 0, SS_Q2 = 4, SS_A = 8, SS_B = 12;
constexpr size_t CTL_ZERO_BYTES = WS_SS + 16 * (size_t)SEQ * 8;
constexpr int LDS_BYTES = 147456;
constexpr int NWAVES = 8;

typedef unsigned short bf16;
typedef float f32x4 __attribute__((ext_vector_type(4)));
typedef short bf16x8 __attribute__((ext_vector_type(8)));
typedef unsigned u32x4 __attribute__((ext_vector_type(4)));
typedef unsigned u32x2 __attribute__((ext_vector_type(2)));
using pg8::pkbf; using pg8::ss_t; using pg8::ss_add; using pg8::ss_get;
__device__ __forceinline__ float bflo(unsigned w) { return __uint_as_float(w << 16); }
__device__ __forceinline__ float bfhi(unsigned w) { return __uint_as_float(w & 0xffff0000u); }
__device__ __forceinline__ float wave_sum(float v) {
#pragma unroll
    for (int o = 1; o < 64; o <<= 1) v += __shfl_xor(v, o);
    return v;
}

struct Args {
    const float *x, *rel_bias, *norm1_g, *w_in, *sgu_norm_g, *sgu_w, *sgu_b, *q_norm_g, *k_norm_g, *sinks, *out_norm_a, *out_norm_b, *w_out, *norm2_g, *w_gate, *w_up, *w_down;
    float* out; unsigned char* ws;
    int never, pad;
};

constexpr int TSCR = 64 * 65 * 4;
__device__ __forceinline__ void transpose_item(const float* W, int K, int N, bf16* WT, int k0, int n0, int dst_row0, const float* gain_k0, float* scr, int lane) {
    const int r = lane >> 4, q = lane & 15;
    const float* src = W + (size_t)(k0 + r) * N + n0 + 4 * q;
    f32x4 v[16];
#pragma unroll
    for (int i = 0; i < 16; ++i) v[i] = __builtin_nontemporal_load((const f32x4*)(src + (size_t)(4 * i) * N));
#pragma unroll
    for (int i = 0; i < 16; ++i) { float* d = scr + (4 * i + r) * 65 + 4 * q; d[0] = v[i].x; d[1] = v[i].y; d[2] = v[i].z; d[3] = v[i].w; }
    asm volatile("s_waitcnt lgkmcnt(0)" ::: "memory");
    const int c = lane & 7;
    f32x4 g0 = (f32x4){1.f, 1.f, 1.f, 1.f}, g1 = g0;
    if (gain_k0) { g0 = *(const f32x4*)(gain_k0 + 8 * c); g1 = *(const f32x4*)(gain_k0 + 8 * c + 4); }
#pragma unroll
    for (int j = 0; j < 8; ++j) { const int n = (lane >> 3) + 8 * j; const float* s = scr + (8 * c) * 65 + n;
        u32x4 o; o.x = pkbf(s[0 * 65] * g0.x, s[1 * 65] * g0.y); o.y = pkbf(s[2 * 65] * g0.z, s[3 * 65] * g0.w); o.z = pkbf(s[4 * 65] * g1.x, s[5 * 65] * g1.y); o.w = pkbf(s[6 * 65] * g1.z, s[7 * 65] * g1.w);
        pg8::store16_wt(WT + (size_t)(dst_row0 + n) * K + k0 + 8 * c, o); }
    asm volatile("s_waitcnt lgkmcnt(0)" ::: "memory");
}
__device__ __forceinline__ void prologue_rows(const float* X, bf16* XB, ss_t* ssq, int gw, int NGW, int lane) {
    for (int m = gw; m < SEQ; m += NGW) {
        const f32x4* xr = (const f32x4*)(X + (size_t)m * DM) + lane;
        f32x4 v[8]; float ss = 0.f;
#pragma unroll
        for (int j = 0; j < 8; ++j) { v[j] = xr[64 * j]; ss += (v[j].x * v[j].x + v[j].y * v[j].y) + (v[j].z * v[j].z + v[j].w * v[j].w); }
        ss = wave_sum(ss); if (lane == 0) { const float fl = floorf(ss); ssq[m] = ((ss_t)(unsigned)fl << 32) | (ss_t)(unsigned)((ss - fl) * 4294967296.0f); }
        u32x2* o = (u32x2*)(XB + (size_t)m * DM) + lane;
#pragma unroll
        for (int j = 0; j < 8; ++j) { u32x2 w; w.x = pkbf(v[j].x, v[j].y); w.y = pkbf(v[j].z, v[j].w); o[64 * j] = w; }
    }
}
#define LAS __attribute__((address_space(3)))
#define XB_TMO      128
#define XB_XCNT(j)  (256  + 64 * (j))
#define XB_XSUB(j)  (1280 + 64 * (j))
#define XB_XGEN(j)  (2304 + 64 * (j))
#define XB_TOP      3328
#define XB_TOPGEN   3392
#define XCD_BAR_WORDS 3456
#define XB_SPIN_CAP (1u << 18)

__device__ __forceinline__ unsigned xb_ld(unsigned* p)              { return __hip_atomic_load(p, __ATOMIC_RELAXED, __HIP_MEMORY_SCOPE_AGENT); }
__device__ __forceinline__ unsigned xb_add(unsigned* p, unsigned v) { return __hip_atomic_fetch_add(p, v, __ATOMIC_RELAXED, __HIP_MEMORY_SCOPE_AGENT); }
__device__ __forceinline__ unsigned xb_xcc_id() { return (unsigned)__builtin_amdgcn_s_getreg((3 << 11) | 20) & 0xFu; }
#define XB_SPIN(cond, bar) do { unsigned _sp = 0; while (cond) { __builtin_amdgcn_s_sleep(1); \
    if ((++_sp & 255u) == 0u) { if (xb_ld(&(bar)[XB_TMO])) break; if (_sp > XB_SPIN_CAP) { atomicAdd(&(bar)[XB_TMO], 1u); break; } } } } while (0)

struct XcdBarrier {
    unsigned* bar; unsigned x;
    volatile LAS unsigned* st;
};

__device__ __forceinline__ XcdBarrier xcd_barrier_post(unsigned* bar, volatile LAS unsigned* st) {
    XcdBarrier b; b.bar = bar; b.x = xb_xcc_id(); b.st = st;
    if (threadIdx.x == 0) (void)xb_add(&bar[XB_XCNT(b.x)], 1u);
    return b;
}
__device__ __forceinline__ void xcd_barrier_complete(unsigned* bar, unsigned x, unsigned& nloc, unsigned& nx) {
    const unsigned G = gridDim.x * gridDim.y * gridDim.z;
    unsigned sum, cnt, mine, sp = 0u;
    for (;;) {
        sum = 0u; cnt = 0u; mine = 0u;
#pragma unroll
        for (unsigned j = 0; j < 16; ++j) { const unsigned c = xb_ld(&bar[XB_XCNT(j)]); sum += c; cnt += (c > 0u) ? 1u : 0u; mine = (j == x) ? c : mine; }
        if (sum == G) break;
        __builtin_amdgcn_s_sleep(1);
        if ((++sp & 255u) == 0u) { if (xb_ld(&bar[XB_TMO])) break; if (sp > XB_SPIN_CAP) { atomicAdd(&bar[XB_TMO], 1u); break; } }
    }
    nloc = mine > 0u ? mine : 1u; nx = cnt > 0u ? cnt : 1u;
}

template <bool RELEASE> __device__ __forceinline__ void xcd_barrier_t(const XcdBarrier& b) {
    asm volatile("s_waitcnt vmcnt(0)" ::: "memory");
    __syncthreads();
    if (threadIdx.x == 0) {
        unsigned* bar = b.bar;
        __builtin_amdgcn_s_waitcnt(0);
        unsigned nloc = b.st[0], nx = b.st[1];
        if (nloc == 0u) { xcd_barrier_complete(bar, b.x, nloc, nx); b.st[0] = nloc; b.st[1] = nx; }
        const unsigned old = xb_add(&bar[XB_XSUB(b.x)], 1u);
        const unsigned gen = old / nloc;
        if (old + 1u == (gen + 1u) * nloc) {
            if (RELEASE) __builtin_amdgcn_fence(__ATOMIC_RELEASE, "agent");
            asm volatile("s_waitcnt vmcnt(0)" ::: "memory");
            const unsigned og = xb_add(&bar[XB_TOP], 1u);
            const unsigned tg = og / nx;
            if (og + 1u == (tg + 1u) * nx) xb_add(&bar[XB_TOPGEN], 1u);
            else XB_SPIN(xb_ld(&bar[XB_TOPGEN]) == tg, bar);
            __builtin_amdgcn_fence(__ATOMIC_ACQUIRE, "agent");
            xb_add(&bar[XB_XGEN(b.x)], 1u);
            asm volatile("s_waitcnt vmcnt(0)" ::: "memory");
        } else {
            XB_SPIN(xb_ld(&bar[XB_XGEN(b.x)]) == gen, bar);
            __builtin_amdgcn_fence(__ATOMIC_ACQUIRE, "agent");
            asm volatile("s_waitcnt vmcnt(0)" ::: "memory");
        }
    }
    __syncthreads();
}

__device__ __forceinline__ void xcd_barrier(const XcdBarrier& b) { xcd_barrier_t<true>(b); }

#define LB_SUB(j) (4096 + 64 * (j))
#define LB_GEN(j) (5120 + 64 * (j))
__device__ __forceinline__ void xcc_local_barrier(unsigned* bar, unsigned x, unsigned nloc) {
    asm volatile("s_waitcnt vmcnt(0)" ::: "memory");
    __syncthreads();
    if (threadIdx.x == 0) {
        __builtin_amdgcn_s_waitcnt(0);
        const unsigned old = xb_add(&bar[LB_SUB(x)], 1u);
        const unsigned gen = old / nloc;
        if (old + 1u == (gen + 1u) * nloc) xb_add(&bar[LB_GEN(x)], 1u);
        else XB_SPIN(xb_ld(&bar[LB_GEN(x)]) == gen, bar);
        __builtin_amdgcn_fence(__ATOMIC_ACQUIRE, "agent");
        asm volatile("s_waitcnt vmcnt(0)" ::: "memory");
    }
    __syncthreads();
}
constexpr int KS_STRIDE = 72;
constexpr int VT_STRIDE = 264;
constexpr int LDS_KS = 0, LDS_VT = 256 * KS_STRIDE * 2, LDS_BT = LDS_VT + 64 * VT_STRIDE * 2;
constexpr int VN_STRIDE = 136;
#define MFMA16(a, b, c) __builtin_amdgcn_mfma_f32_16x16x32_bf16((a), (b), (c), 0, 0, 0)

__device__ __forceinline__ int t5_bucket(int n) {
    if (n < 16) return n;
    const float v = logf((float)n / 16.0f) / 2.0794415416798357f * 16.0f;
    int b = 16 + (int)v; return b < 31 ? b : 31;
}

__device__ __forceinline__ void attn_load_q(u32x4 (&q0)[2], const bf16* Z, int n, int kvh, int wid, int lane) {
    const int g = wid >> 1, qh = wid & 1, hq = kvh * 4 + g, fr = lane & 15, fq = lane >> 4;
    const bf16* qp = Z + (size_t)(n * 128 + 64 * qh + fr) * INW + QCOL + hq * 64; q0[0] = *(const u32x4*)(qp + 8 * fq); q0[1] = *(const u32x4*)(qp + 32 + 8 * fq);
}
template <int PAR> __device__ __forceinline__ void attn_sub(const bf16* KS, const bf16* VT, const float* BTg, const float* gq, float sink2, int n, int ti, int hq, const u32x4 w0, const u32x4 w1, bf16* MIX, ss_t* ssb, int lane) {
    const int fr = lane & 15, fq = lane >> 4; const int qi = 16 * ti + fr, tb = ti - PAR; const int tok = n * 128 + qi;
    bf16x8 qf[2];
    { float f0[8], f1[8]; float ss = 0.f;
#pragma unroll
      for (int e = 0; e < 4; ++e) { f0[2 * e] = bflo(w0[e]); f0[2 * e + 1] = bfhi(w0[e]); f1[2 * e] = bflo(w1[e]); f1[2 * e + 1] = bfhi(w1[e]);
          ss += (f0[2 * e] * f0[2 * e] + f0[2 * e + 1] * f0[2 * e + 1]) + (f1[2 * e] * f1[2 * e] + f1[2 * e + 1] * f1[2 * e + 1]); }
      ss += __shfl_xor(ss, 16); ss += __shfl_xor(ss, 32);
      const float rs = (0.125f * 1.4426950408889634f) / sqrtf(ss * (1.0f / 64.f) + EPS);
      const f32x4 a0 = *(const f32x4*)(gq + 8 * fq), a1 = *(const f32x4*)(gq + 8 * fq + 4), b0 = *(const f32x4*)(gq + 32 + 8 * fq), b1 = *(const f32x4*)(gq + 32 + 8 * fq + 4);
      u32x4 p0, p1;
      p0.x = pkbf(f0[0] * rs * a0.x, f0[1] * rs * a0.y); p0.y = pkbf(f0[2] * rs * a0.z, f0[3] * rs * a0.w); p0.z = pkbf(f0[4] * rs * a1.x, f0[5] * rs * a1.y); p0.w = pkbf(f0[6] * rs * a1.z, f0[7] * rs * a1.w);
      p1.x = pkbf(f1[0] * rs * b0.x, f1[1] * rs * b0.y); p1.y = pkbf(f1[2] * rs * b0.z, f1[3] * rs * b0.w); p1.z = pkbf(f1[4] * rs * b1.x, f1[5] * rs * b1.y); p1.w = pkbf(f1[6] * rs * b1.z, f1[7] * rs * b1.w);
      qf[0] = __builtin_bit_cast(bf16x8, p0); qf[1] = __builtin_bit_cast(bf16x8, p1); }
    const int e0 = 4 * fq - fr;
    const float* bp = BTg + (128 - 16 * 8 - 3 - e0);
    f32x4 sc[10]; float mx = sink2;
#pragma unroll
    for (int t = 0; t < 10; ++t) {
        constexpr int dummy = 0; (void)dummy;
        const int rel = t - PAR;
        if (rel < 0 || rel > 8) { sc[t] = (f32x4){0.f, 0.f, 0.f, 0.f}; continue; }
        const bf16* kp = KS + (16 * (tb + t) + fr) * KS_STRIDE + 8 * fq;
        const bf16x8 k0 = *(const bf16x8*)kp, k1 = *(const bf16x8*)(kp + 32);
        f32x4 acc = (f32x4){0.f, 0.f, 0.f, 0.f};
        acc = MFMA16(k0, qf[0], acc); acc = MFMA16(k1, qf[1], acc);
        const bool tv = (n > 0) || (tb + t >= 8);
#pragma unroll
        for (int r = 0; r < 4; ++r) { bool valid = tv; if (rel == 0) valid = valid && (e0 + r >= 1); if (rel == 8) valid = valid && (e0 + r <= 0);
            const float v = valid ? acc[r] + bp[16 * (8 - rel) + (3 - r)] : -1e30f; acc[r] = v; mx = fmaxf(mx, v); }
        sc[t] = acc;
    }
    mx = fmaxf(mx, __shfl_xor(mx, 16)); mx = fmaxf(mx, __shfl_xor(mx, 32));
    float lsum = 0.f;
#pragma unroll
    for (int t = 0; t < 10; ++t) { const int rel = t - PAR; if (rel < 0 || rel > 8) continue;
#pragma unroll
        for (int r = 0; r < 4; ++r) { const float p = __builtin_amdgcn_exp2f(sc[t][r] - mx); sc[t][r] = p; lsum += p; } }
    lsum += __shfl_xor(lsum, 16); lsum += __shfl_xor(lsum, 32);
    lsum += __builtin_amdgcn_exp2f(sink2 - mx);
    const float rl = 1.0f / lsum;
    f32x4 o[4];
#pragma unroll
    for (int dt = 0; dt < 4; ++dt) o[dt] = (f32x4){0.f, 0.f, 0.f, 0.f};
#pragma unroll
    for (int p = 0; p < 5; ++p) {
        u32x4 pw; pw.x = pkbf(sc[2 * p][0], sc[2 * p][1]); pw.y = pkbf(sc[2 * p][2], sc[2 * p][3]); pw.z = pkbf(sc[2 * p + 1][0], sc[2 * p + 1][1]); pw.w = pkbf(sc[2 * p + 1][2], sc[2 * p + 1][3]);
        const bf16x8 pb = __builtin_bit_cast(bf16x8, pw);
#pragma unroll
        for (int dt = 0; dt < 4; ++dt) {
            const bf16* vp = VT + (16 * dt + fr) * VT_STRIDE + 16 * (tb + 2 * p) + 4 * fq;
            const u32x2 lo = *(const u32x2*)vp, hi = *(const u32x2*)(vp + 16);
            const u32x4 va = (u32x4){lo.x, lo.y, hi.x, hi.y};
            o[dt] = MFMA16(__builtin_bit_cast(bf16x8, va), pb, o[dt]);
        }
    }
    bf16* op = MIX + (size_t)tok * DM + 1024 + hq * 64 + 4 * fq;
    float sq = 0.f;
#pragma unroll
    for (int dt = 0; dt < 4; ++dt) { const f32x4 v = o[dt] * rl; sq += (v[0] * v[0] + v[1] * v[1]) + (v[2] * v[2] + v[3] * v[3]); u32x2 w; w.x = pkbf(v[0], v[1]); w.y = pkbf(v[2], v[3]); *(u32x2*)(op + 16 * dt) = w; }
    sq += __shfl_xor(sq, 16); sq += __shfl_xor(sq, 32); if (fq == 0) ss_add(ssb + tok, sq);
}
__device__ __forceinline__ void attn_compute(const Args& A, int l, int n, int kvh, const u32x4 (&q0)[2], const bf16* Z, bf16* MIX, ss_t* ssb, unsigned char* lds, int wid, int lane) {
    const bf16* KS = (const bf16*)(lds + LDS_KS); const bf16* VT = (const bf16*)(lds + LDS_VT); const float* BT = (const float*)(lds + LDS_BT);
    const float* gq = A.q_norm_g + l * 64;
    const int g = wid >> 1, qh = wid & 1, hq = kvh * 4 + g; const int fr = lane & 15, fq = lane >> 4;
    const float sink2 = A.sinks[l * 16 + hq] * 1.4426950408889634f;
    const float* BTg = BT + g * 128;
    u32x4 qc0 = q0[0], qc1 = q0[1];
#pragma nounroll
    for (int ip = 0; ip < 2; ++ip) {
        const int ti = 4 * qh + 2 * ip;
        const bf16* qp = Z + (size_t)(n * 128 + 16 * ti + fr) * INW + QCOL + hq * 64;
        u32x4 w0 = qc0, w1 = qc1;
        qc0 = *(const u32x4*)(qp + (size_t)16 * INW + 8 * fq); qc1 = *(const u32x4*)(qp + (size_t)16 * INW + 32 + 8 * fq);
        attn_sub<0>(KS, VT, BTg, gq, sink2, n, ti, hq, w0, w1, MIX, ssb, lane);
        w0 = qc0; w1 = qc1;
        if (ip == 0) { qc0 = *(const u32x4*)(qp + (size_t)32 * INW + 8 * fq); qc1 = *(const u32x4*)(qp + (size_t)32 * INW + 32 + 8 * fq); }
        attn_sub<1>(KS, VT, BTg, gq, sink2, n, ti + 1, hq, w0, w1, MIX, ssb, lane);
    }
}

__device__ __forceinline__ void attn_unit(const Args& A, int l, int n, int kvh, const bf16* Z, bf16* MIX, ss_t* ssb, unsigned char* lds, int tid, int wid, int lane) {
    bf16* KS = (bf16*)(lds + LDS_KS); bf16* VT = (bf16*)(lds + LDS_VT); float* BT = (float*)(lds + LDS_BT);
    const float* gk = A.k_norm_g + l * 64; const float* gq = A.q_norm_g + l * 64;
#pragma unroll
    for (int i = 0; i < 4; ++i) {
        const int id = tid + 512 * i, row = id >> 3, ch = id & 7; const int tok = (n - 1) * 128 + row;
        u32x4 kw = (u32x4){0u, 0u, 0u, 0u}, vw = (u32x4){0u, 0u, 0u, 0u};
        if (tok >= 0) { const bf16* zr = Z + (size_t)tok * INW; kw = *(const u32x4*)(zr + KCOL + kvh * 64 + ch * 8); vw = *(const u32x4*)(zr + VCOL + kvh * 64 + ch * 8); }
        float f[8]; float ss = 0.f;
#pragma unroll
        for (int e = 0; e < 4; ++e) { f[2 * e] = bflo(kw[e]); f[2 * e + 1] = bfhi(kw[e]); ss += f[2 * e] * f[2 * e] + f[2 * e + 1] * f[2 * e + 1]; }
        ss += __shfl_xor(ss, 1); ss += __shfl_xor(ss, 2); ss += __shfl_xor(ss, 4);
        const float rstd = 1.0f / sqrtf(ss * (1.0f / 64.f) + EPS);
        const f32x4 g0 = *(const f32x4*)(gk + ch * 8), g1 = *(const f32x4*)(gk + ch * 8 + 4);
        u32x4 o; o.x = pkbf(f[0] * rstd * g0.x, f[1] * rstd * g0.y); o.y = pkbf(f[2] * rstd * g0.z, f[3] * rstd * g0.w); o.z = pkbf(f[4] * rstd * g1.x, f[5] * rstd * g1.y); o.w = pkbf(f[6] * rstd * g1.z, f[7] * rstd * g1.w);
        *(u32x4*)(KS + row * KS_STRIDE + ch * 8) = o;
#pragma unroll
        for (int e = 0; e < 4; ++e) { VT[(ch * 8 + 2 * e) * VT_STRIDE + row] = (bf16)(vw[e] & 0xffffu); VT[(ch * 8 + 2 * e + 1) * VT_STRIDE + row] = (bf16)(vw[e] >> 16); }
    }
    { const int g = tid >> 7, dist = tid & 127; BT[g * 128 + dist] = A.rel_bias[t5_bucket(dist) * 16 + kvh * 4 + g] * 1.4426950408889634f; }
    __syncthreads();
    { u32x4 q0[2]; attn_load_q(q0, Z, n, kvh, wid, lane); attn_compute(A, l, n, kvh, q0, Z, MIX, ssb, lds, wid, lane); }
    __syncthreads();
}

__device__ __forceinline__ void sgu_unit(const Args& A, int l, int c, int h, const bf16* Z, bf16* MIX, ss_t* ssa, unsigned char* lds, int tid, int wid, int lane) {
    bf16* VN = (bf16*)lds;
    const float* gs = A.sgu_norm_g + (l * 16 + h) * 64;
#pragma unroll
    for (int i = 0; i < 2; ++i) {
        const int id = tid + 512 * i, row = id >> 3, ch = id & 7;
        const u32x4 vw = *(const u32x4*)(Z + (size_t)(c * 128 + row) * INW + 1024 + h * 64 + ch * 8);
        float f[8]; float ss = 0.f;
#pragma unroll
        for (int e = 0; e < 4; ++e) { f[2 * e] = bflo(vw[e]); f[2 * e + 1] = bfhi(vw[e]); ss += f[2 * e] * f[2 * e] + f[2 * e + 1] * f[2 * e + 1]; }
        ss += __shfl_xor(ss, 1); ss += __shfl_xor(ss, 2); ss += __shfl_xor(ss, 4);
        const float rstd = 1.0f / sqrtf(ss * (1.0f / 64.f) + EPS);
#pragma unroll
        for (int e = 0; e < 8; e += 2) { const unsigned w = pkbf(f[e] * rstd * gs[ch * 8 + e], f[e + 1] * rstd * gs[ch * 8 + e + 1]);
            VN[(ch * 8 + e) * VN_STRIDE + row] = (bf16)(w & 0xffffu); VN[(ch * 8 + e + 1) * VN_STRIDE + row] = (bf16)(w >> 16); }
    }
    __syncthreads();
    const int fr = lane & 15, fq = lane >> 4; const int t = 16 * wid + fr; const int nks = (wid >> 1) + 1;
    const float* wrow = A.sgu_w + ((size_t)(l * 16 + h) * 128 + t) * 128;
    bf16x8 bfr[4];
#pragma unroll
    for (int ks = 0; ks < 4; ++ks) {
        u32x4 w = (u32x4){0u, 0u, 0u, 0u};
        if (ks < nks) { const int s0 = 32 * ks + 8 * fq; const f32x4 a = *(const f32x4*)(wrow + s0), b = *(const f32x4*)(wrow + s0 + 4);
            float f[8] = {a.x, a.y, a.z, a.w, b.x, b.y, b.z, b.w};
#pragma unroll
            for (int e = 0; e < 8; ++e) f[e] = (s0 + e <= t) ? f[e] : 0.f;
            w.x = pkbf(f[0], f[1]); w.y = pkbf(f[2], f[3]); w.z = pkbf(f[4], f[5]); w.w = pkbf(f[6], f[7]); }
        bfr[ks] = __builtin_bit_cast(bf16x8, w);
    }
    const float bias = A.sgu_b[(l * 16 + h) * 128 + t];
    const size_t tok = (size_t)(c * 128 + t); float sq = 0.f;
#pragma unroll
    for (int dt = 0; dt < 4; ++dt) {
        f32x4 acc = (f32x4){0.f, 0.f, 0.f, 0.f};
#pragma unroll
        for (int ks = 0; ks < 4; ++ks) if (ks < nks) { const bf16x8 a = *(const bf16x8*)(VN + (16 * dt + fr) * VN_STRIDE + 32 * ks + 8 * fq); acc = MFMA16(a, bfr[ks], acc); }
        const int d0 = h * 64 + 16 * dt + 4 * fq;
        const u32x2 uw = *(const u32x2*)(Z + tok * INW + d0);
        const float v0 = bflo(uw.x) * (acc[0] + bias), v1 = bfhi(uw.x) * (acc[1] + bias), v2 = bflo(uw.y) * (acc[2] + bias), v3 = bfhi(uw.y) * (acc[3] + bias);
        sq += (v0 * v0 + v1 * v1) + (v2 * v2 + v3 * v3);
        u32x2 w; w.x = pkbf(v0, v1); w.y = pkbf(v2, v3);
        *(u32x2*)(MIX + tok * DM + d0) = w;
    }
    sq += __shfl_xor(sq, 16); sq += __shfl_xor(sq, 32); if (fq == 0) ss_add(ssa + tok, sq);
    __syncthreads();
}
constexpr int LDS_VN0 = LDS_BT + 2048;
static_assert(LDS_VN0 + 4 * 64 * VN_STRIDE * 2 <= LDS_BYTES - 16, "mixer LDS map");
__device__ __forceinline__ void mixer_phase256(const Args& A, int l, int vc, const bf16* Z, bf16* MIX, ss_t* ssa, ss_t* ssb, unsigned char* lds, int tid, int wid, int lane) {
    bf16* KS = (bf16*)(lds + LDS_KS); bf16* VT = (bf16*)(lds + LDS_VT); float* BT = (float*)(lds + LDS_BT); bf16* VN = (bf16*)(lds + LDS_VN0);
    const int gx = vc & 7, gj = vc >> 3;
    const int n = 8 * gx + (gj >> 2), kvh = gj & 3, h = gj & 15, cb = 8 * gx + 4 * (gj >> 4);
    const int fr = lane & 15, fq = lane >> 4;
    const bool isK = tid < 256; const int arow = tid & 255; const int atok = (n - 1) * 128 + arow;
    u32x4 aw[8], sw[8];
    { const bf16* ap = Z + (size_t)(atok < 0 ? 0 : atok) * INW + (isK ? KCOL : VCOL) + kvh * 64;
#pragma unroll
      for (int c = 0; c < 8; ++c) aw[c] = *(const u32x4*)(ap + 8 * c); }
    const int srow = tid & 127, sj = tid >> 7;
    { const bf16* sp = Z + (size_t)((cb + sj) * 128 + srow) * INW + 1024 + h * 64;
#pragma unroll
      for (int c = 0; c < 8; ++c) sw[c] = *(const u32x4*)(sp + 8 * c); }
    const int st = 16 * wid + fr; const int nks = (wid >> 1) + 1;
    const float* wrow = A.sgu_w + ((size_t)(l * 16 + h) * 128 + st) * 128;
    f32x4 wa[4][2];
#pragma unroll
    for (int ks = 0; ks < 4; ++ks) { wa[ks][0] = (f32x4){0.f, 0.f, 0.f, 0.f}; wa[ks][1] = wa[ks][0];
        if (ks < nks) { wa[ks][0] = *(const f32x4*)(wrow + 32 * ks + 8 * fq); wa[ks][1] = *(const f32x4*)(wrow + 32 * ks + 8 * fq + 4); } }
    const float sbias = A.sgu_b[(l * 16 + h) * 128 + st];
    { const int g = tid >> 7, dist = tid & 127; BT[g * 128 + dist] = A.rel_bias[t5_bucket(dist) * 16 + kvh * 4 + g] * 1.4426950408889634f; }
    if (atok < 0) {
#pragma unroll
        for (int c = 0; c < 8; ++c) aw[c] = (u32x4){0u, 0u, 0u, 0u}; }
    if (isK) {
        const float* gk = A.k_norm_g + l * 64; float ss = 0.f;
#pragma unroll
        for (int c = 0; c < 8; ++c)
#pragma unroll
            for (int e = 0; e < 4; ++e) { const float a = bflo(aw[c][e]), b = bfhi(aw[c][e]); ss += a * a + b * b; }
        const float rstd = 1.0f / sqrtf(ss * (1.0f / 64.f) + EPS);
#pragma unroll
        for (int c = 0; c < 8; ++c) { const f32x4 g0 = *(const f32x4*)(gk + 8 * c), g1 = *(const f32x4*)(gk + 8 * c + 4); u32x4 o;
            o.x = pkbf(bflo(aw[c].x) * rstd * g0.x, bfhi(aw[c].x) * rstd * g0.y); o.y = pkbf(bflo(aw[c].y) * rstd * g0.z, bfhi(aw[c].y) * rstd * g0.w);
            o.z = pkbf(bflo(aw[c].z) * rstd * g1.x, bfhi(aw[c].z) * rstd * g1.y); o.w = pkbf(bflo(aw[c].w) * rstd * g1.z, bfhi(aw[c].w) * rstd * g1.w);
            *(u32x4*)(KS + arow * KS_STRIDE + 8 * c) = o; }
    } else {
#pragma unroll
        for (int c = 0; c < 8; ++c)
#pragma unroll
            for (int e = 0; e < 4; ++e) { VT[(8 * c + 2 * e) * VT_STRIDE + arow] = (bf16)(aw[c][e] & 0xffffu); VT[(8 * c + 2 * e + 1) * VT_STRIDE + arow] = (bf16)(aw[c][e] >> 16); }
    }
    { const float* gs = A.sgu_norm_g + (l * 16 + h) * 64; float ss = 0.f; bf16* vn = VN + sj * 64 * VN_STRIDE;
#pragma unroll
      for (int c = 0; c < 8; ++c)
#pragma unroll
          for (int e = 0; e < 4; ++e) { const float a = bflo(sw[c][e]), b = bfhi(sw[c][e]); ss += a * a + b * b; }
      const float rstd = 1.0f / sqrtf(ss * (1.0f / 64.f) + EPS);
#pragma unroll
      for (int c = 0; c < 8; ++c) { const f32x4 g0 = *(const f32x4*)(gs + 8 * c), g1 = *(const f32x4*)(gs + 8 * c + 4); const float gg[8] = {g0.x, g0.y, g0.z, g0.w, g1.x, g1.y, g1.z, g1.w};
#pragma unroll
          for (int e = 0; e < 4; ++e) { const unsigned w = pkbf(bflo(sw[c][e]) * rstd * gg[2 * e], bfhi(sw[c][e]) * rstd * gg[2 * e + 1]);
              vn[(8 * c + 2 * e) * VN_STRIDE + srow] = (bf16)(w & 0xffffu); vn[(8 * c + 2 * e + 1) * VN_STRIDE + srow] = (bf16)(w >> 16); } }
    }
    asm volatile("" ::: "memory");
    u32x4 q0[2]; attn_load_q(q0, Z, n, kvh, wid, lane);
    u32x2 uw[4][4];
#pragma unroll
    for (int j = 0; j < 4; ++j)
#pragma unroll
        for (int dt = 0; dt < 4; ++dt) uw[j][dt] = *(const u32x2*)(Z + (size_t)((cb + j) * 128 + st) * INW + h * 64 + 16 * dt + 4 * fq);
    __syncthreads();
    {
        bf16x8 bfr[4];
#pragma unroll
        for (int ks = 0; ks < 4; ++ks) { float f[8] = {wa[ks][0].x, wa[ks][0].y, wa[ks][0].z, wa[ks][0].w, wa[ks][1].x, wa[ks][1].y, wa[ks][1].z, wa[ks][1].w}; const int s0 = 32 * ks + 8 * fq;
#pragma unroll
            for (int e = 0; e < 8; ++e) f[e] = (s0 + e <= st) ? f[e] : 0.f;
            u32x4 w; w.x = pkbf(f[0], f[1]); w.y = pkbf(f[2], f[3]); w.z = pkbf(f[4], f[5]); w.w = pkbf(f[6], f[7]); bfr[ks] = __builtin_bit_cast(bf16x8, w); }
#pragma unroll
        for (int j = 0; j < 4; ++j) {
            const bf16* vn = VN + j * 64 * VN_STRIDE; const size_t tok = (size_t)((cb + j) * 128 + st); float sq = 0.f;
#pragma unroll
            for (int dt = 0; dt < 4; ++dt) {
                f32x4 acc = (f32x4){0.f, 0.f, 0.f, 0.f};
#pragma unroll
                for (int ks = 0; ks < 4; ++ks) if (ks < nks) { const bf16x8 a = *(const bf16x8*)(vn + (16 * dt + fr) * VN_STRIDE + 32 * ks + 8 * fq); acc = MFMA16(a, bfr[ks], acc); }
                const float v0 = bflo(uw[j][dt].x) * (acc[0] + sbias), v1 = bfhi(uw[j][dt].x) * (acc[1] + sbias), v2 = bflo(uw[j][dt].y) * (acc[2] + sbias), v3 = bfhi(uw[j][dt].y) * (acc[3] + sbias);
                sq += (v0 * v0 + v1 * v1) + (v2 * v2 + v3 * v3);
                u32x2 w; w.x = pkbf(v0, v1); w.y = pkbf(v2, v3);
                *(u32x2*)(MIX + tok * DM + h * 64 + 16 * dt + 4 * fq) = w;
            }
            sq += __shfl_xor(sq, 16); sq += __shfl_xor(sq, 32); if (fq == 0) ss_add(ssa + tok, sq);
        }
    }
    attn_compute(A, l, n, kvh, q0, Z, MIX, ssb, lds, wid, lane);
}
constexpr int I_IN = (DM / 64) * (INW / 64), I_OUT = (DM / 64) * (DM / 64), I_G = (DM / 64) * (DFF / 64), I_DN = (DFF / 64) * (DM / 64);
constexpr int PER_LAYER = I_IN + I_OUT + 2 * I_G + I_DN;
constexpr int Q_P = 5500, Q_G1 = 3000, Q_G3 = 8500, N_ALL = DEPTH * PER_LAYER;
constexpr bool queue_ok() {
    for (int l = 0; l < DEPTH; ++l) {
        const long c1 = Q_P + (long)l * (Q_G1 + Q_G3) + Q_G1, c3 = Q_P + (long)(l + 1) * (Q_G1 + Q_G3);
        const long r1 = (long)l * PER_LAYER + I_IN + I_OUT + 2 * I_G, r3 = (long)(l + 1) * PER_LAYER + (l + 1 < DEPTH ? I_IN : 0);
        if (c1 < r1 || c3 < r3) return false;
    }
    return Q_P >= I_IN;
}
static_assert(queue_ok(), "conversion queue deadlines");
__device__ __forceinline__ void convert_items(const Args& A, unsigned char* ws, int g0, int g1, int w, int nw, float* scr, int lane) {
    for (int it = g0 + w; it < g1; it += nw) {
        const int l = it / PER_LAYER; int r = it % PER_LAYER;
        if (r < I_IN) { const int nb = INW / 64, kb = r / nb, n0 = 64 * (r % nb); transpose_item(A.w_in + (size_t)l * DM * INW, DM, INW, (bf16*)(ws + WS_WIN + l * SZ_WIN), 64 * kb, n0, n0, A.norm1_g + l * DM + 64 * kb, scr, lane); continue; } r -= I_IN;
        if (r < I_OUT) { const int nb = DM / 64, kb = r / nb, n0 = 64 * (r % nb); transpose_item(A.w_out + (size_t)l * DM * DM, DM, DM, (bf16*)(ws + WS_WOUT + l * SZ_WOUT), 64 * kb, n0, n0, (kb < 16 ? A.out_norm_a + l * 1024 + 64 * kb : A.out_norm_b + l * 1024 + 64 * (kb - 16)), scr, lane); continue; } r -= I_OUT;
        if (r < I_G) { const int nb = DFF / 64, kb = r / nb, n0 = 64 * (r % nb); transpose_item(A.w_gate + (size_t)l * DM * DFF, DM, DFF, (bf16*)(ws + WS_WGU + l * SZ_WGU), 64 * kb, n0, 256 * (n0 / 128) + (n0 % 128), A.norm2_g + l * DM + 64 * kb, scr, lane); continue; } r -= I_G;
        if (r < I_G) { const int nb = DFF / 64, kb = r / nb, n0 = 64 * (r % nb); transpose_item(A.w_up + (size_t)l * DM * DFF, DM, DFF, (bf16*)(ws + WS_WGU + l * SZ_WGU), 64 * kb, n0, 256 * (n0 / 128) + 128 + (n0 % 128), A.norm2_g + l * DM + 64 * kb, scr, lane); continue; } r -= I_G;
        { const int nb = DM / 64, kb = r / nb, n0 = 64 * (r % nb); transpose_item(A.w_down + (size_t)l * DFF * DM, DFF, DM, (bf16*)(ws + WS_WDN + l * SZ_WDN), 64 * kb, n0, n0, nullptr, scr, lane); }
    }
}

__global__ void __launch_bounds__(NWAVES * 64, 2) fwd_kernel(Args A) {
    extern __shared__ __attribute__((aligned(16))) unsigned char lds[];
    cg::grid_group grid = cg::this_grid();
    const int G = gridDim.x, bx = blockIdx.x, NGW = G * NWAVES;
#define PHASE_IDS() int tid = threadIdx.x; asm volatile("" : "+v"(tid)); const int lane = tid & 63, wid = __builtin_amdgcn_readfirstlane(tid >> 6), gw = bx * NWAVES + wid; (void)lane; (void)gw
    unsigned char* ws = A.ws;
    bf16* XB = (bf16*)(ws + WS_XN); ss_t* SS = (ss_t*)(ws + WS_SS); bf16* Z = (bf16*)(ws + WS_Z); bf16* MIX = (bf16*)(ws + WS_MIX); bf16* ACT = (bf16*)(ws + WS_ACT);
    float* X = A.out;
    PG8_LAS unsigned char* ldsl = (PG8_LAS unsigned char*)lds;
    volatile LAS unsigned* bst = (volatile LAS unsigned*)(ldsl + LDS_BYTES - 16);
    if (threadIdx.x < 4) bst[threadIdx.x] = 0u;
    __syncthreads();
    unsigned* barw = (unsigned*)(ws + WS_CTL);
    XcdBarrier bar; bar.bar = barw; bar.st = bst; bar.x = xb_xcc_id();
    if (threadIdx.x == 0) bst[2] = xb_add(&barw[XB_XCNT(bar.x)], 1u);
    __syncthreads();
    const unsigned my_x = bar.x, my_r = (unsigned)__builtin_amdgcn_readfirstlane((int)bst[2]);
#define GRID_BAR() xcd_barrier(bar)

    {
        PHASE_IDS();
        float* scr = (float*)(lds + wid * TSCR);
        const bool lazy = (G == 256);
        convert_items(A, ws, 0, lazy ? Q_P : N_ALL, gw, NGW, scr, lane);
        prologue_rows(A.x, XB, SS + (size_t)SS_Q1 * SEQ, gw, NGW, lane);
    }
    if (A.never) grid.sync();
    GRID_BAR();
    bool tp = (G == 256);
    if (tp) { for (unsigned q = 0; q < 16; ++q) { const unsigned c = xb_ld(&barw[XB_XCNT(q)]); tp = tp && (c == (q < 8 ? 32u : 0u)); } }
    tp = __builtin_amdgcn_readfirstlane((int)tp) != 0;
    const int vc = tp ? (int)(my_r * 8u + my_x) : bx;
#define LOCAL_BAR() do { if (tp) xcc_local_barrier(barw, my_x, 32u); else xcd_barrier(bar); } while (0)
#define GRID_BAR_L() do { if (tp) xcd_barrier_t<false>(bar); else xcd_barrier_t<true>(bar); } while (0)

#pragma nounroll
    for (int l = 0; l < DEPTH; ++l) {
        { pg8::Gemm g{XB, (const bf16*)(ws + WS_WIN + l * SZ_WIN), SEQ, INW, DM};
          pg8::EpiZ E{Z, INW, 8, SS + (size_t)(SS_Q1 + l) * SEQ};
          if (G == 256) { pg8::OrderTok S{vc, INW / 256, 0}; pg8::gemm_phase<pg8::EpiZ, pg8::OrderTok, true, true>(ldsl, g, S, E); }
          else { pg8::StaticOrder S; S.init(SEQ, INW, G, bx); pg8::gemm_phase<pg8::EpiZ, pg8::StaticOrder, true, true>(ldsl, g, S, E); } }
        if (G == 256 && vc >= 192) {
            PHASE_IDS(); const int g0 = Q_P + l * (Q_G1 + Q_G3), g1 = g0 + Q_G1;
            convert_items(A, ws, g0 < N_ALL ? g0 : N_ALL, g1 < N_ALL ? g1 : N_ALL, (vc - 192) * NWAVES + wid, 64 * NWAVES, (float*)(lds + wid * TSCR), lane); }
        GRID_BAR_L();
        { PHASE_IDS();
          if (G == 256) mixer_phase256(A, l, vc, Z, MIX, SS + (size_t)(SS_A + l) * SEQ, SS + (size_t)(SS_B + l) * SEQ, lds, tid, wid, lane);
          else {
            for (int a = bx; a < 256; a += G) attn_unit(A, l, a >> 2, a & 3, Z, MIX, SS + (size_t)(SS_B + l) * SEQ, lds, tid, wid, lane);
            for (int s = bx; s < 1024; s += G) sgu_unit(A, l, s >> 4, s & 15, Z, MIX, SS + (size_t)(SS_A + l) * SEQ, lds, tid, wid, lane); } }
        LOCAL_BAR();
        { pg8::Gemm g{MIX, (const bf16*)(ws + WS_WOUT + l * SZ_WOUT), SEQ, DM, DM};
          pg8::EpiResid<true> E{nullptr, DM, XB, SS + (size_t)(SS_Q2 + l) * SEQ, SS + (size_t)(SS_A + l) * SEQ, SS + (size_t)(SS_B + l) * SEQ};
          if (G == 256) { pg8::OrderTok S{vc, DM / 256, 0}; pg8::gemm_phase<pg8::EpiResid<true>, pg8::OrderTok, true, true>(ldsl, g, S, E); }
          else { pg8::StaticOrder S; S.init(SEQ, DM, G, bx); pg8::gemm_phase<pg8::EpiResid<true>, pg8::StaticOrder, true, true>(ldsl, g, S, E); } }
        LOCAL_BAR();
        { pg8::Gemm g{XB, (const bf16*)(ws + WS_WGU + l * SZ_WGU), SEQ, NGU, DM};
          pg8::EpiSwiGLU E{ACT, DFF, SS + (size_t)(SS_Q2 + l) * SEQ};
          if (G == 256) { pg8::OrderTok S{vc, NGU / 256, 5}; pg8::gemm_phase<pg8::EpiSwiGLU, pg8::OrderTok, true, true>(ldsl, g, S, E); }
          else { pg8::StaticOrder S; S.init(SEQ, NGU, G, bx); pg8::gemm_phase<pg8::EpiSwiGLU, pg8::StaticOrder, true, true>(ldsl, g, S, E); } }
        if (G == 256 && vc >= 128) {
            PHASE_IDS(); const int g0 = Q_P + l * (Q_G1 + Q_G3) + Q_G1, g1 = g0 + Q_G3;
            convert_items(A, ws, g0 < N_ALL ? g0 : N_ALL, g1 < N_ALL ? g1 : N_ALL, (vc - 128) * NWAVES + wid, 128 * NWAVES, (float*)(lds + wid * TSCR), lane); }
        GRID_BAR_L();
        { pg8::Gemm g{ACT, (const bf16*)(ws + WS_WDN + l * SZ_WDN), SEQ, DM, DFF};
          const bool more = l + 1 < DEPTH;
          pg8::EpiResid<false> E{more ? nullptr : X, DM, XB, SS + (size_t)(SS_Q1 + (more ? l + 1 : 0)) * SEQ, nullptr, nullptr};
          if (G == 256) { pg8::OrderTok S{vc, DM / 256, 0}; pg8::gemm_phase<pg8::EpiResid<false>, pg8::OrderTok, true, true>(ldsl, g, S, E); }
          else { pg8::StaticOrder S; S.init(SEQ, DM, G, bx); pg8::gemm_phase<pg8::EpiResid<false>, pg8::StaticOrder, true, true>(ldsl, g, S, E); } }
        if (l + 1 < DEPTH) LOCAL_BAR();
    }
}

extern "C" void kernel_launch(void* const* d_in, const int* in_sizes, int n_in, void* d_out, int out_size, void* d_ws, size_t ws_size, hipStream_t stream) {
    static int grid = 0;
    if (grid == 0) {
        if (n_in != 17 || out_size != SEQ * DM || ws_size < WS_END) { fprintf(stderr, "kernel_launch: unexpected shapes n_in %d out %d ws %zu (need %zu)\n", n_in, out_size, ws_size, (size_t)WS_END); grid = -1; return; }
        int dev = 0, cus = 0, per_cu = 0;
        (void)hipGetDevice(&dev); (void)hipDeviceGetAttribute(&cus, hipDeviceAttributeMultiprocessorCount, dev);
        (void)hipFuncSetAttribute((const void*)fwd_kernel, hipFuncAttributeMaxDynamicSharedMemorySize, LDS_BYTES);
        (void)hipOccupancyMaxActiveBlocksPerMultiprocessor(&per_cu, (const void*)fwd_kernel, NWAVES * 64, LDS_BYTES);
        if (per_cu < 1) { fprintf(stderr, "kernel_launch: occupancy query says %d blocks per CU\n", per_cu); per_cu = 1; }
        grid = cus * per_cu;
        fprintf(stderr, "kernel_launch: grid %d (cus %d x %d), ws %zu need %zu\n", grid, cus, per_cu, ws_size, (size_t)WS_END);
    }
    if (grid < 0) return;
    Args a{};
    a.x = (const float*)d_in[0]; a.rel_bias = (const float*)d_in[1]; a.norm1_g = (const float*)d_in[2]; a.w_in = (const float*)d_in[3]; a.sgu_norm_g = (const float*)d_in[4];
    a.sgu_w = (const float*)d_in[5]; a.sgu_b = (const float*)d_in[6]; a.q_norm_g = (const float*)d_in[7]; a.k_norm_g = (const float*)d_in[8]; a.sinks = (const float*)d_in[9];
    a.out_norm_a = (const float*)d_in[10]; a.out_norm_b = (const float*)d_in[11]; a.w_out = (const float*)d_in[12]; a.norm2_g = (const float*)d_in[13];
    a.w_gate = (const float*)d_in[14]; a.w_up = (const float*)d_in[15]; a.w_down = (const float*)d_in[16];
    a.out = (float*)d_out; a.ws = (unsigned char*)d_ws;
    (void)hipMemsetAsync((char*)d_ws + WS_CTL, 0, CTL_ZERO_BYTES, stream);
    void* args[] = {&a};
    hipError_t e = hipLaunchCooperativeKernel((const void*)fwd_kernel, dim3(grid), dim3(NWAVES * 64), args, LDS_BYTES, stream);
    if (e != hipSuccess) fprintf(stderr, "kernel_launch: cooperative launch failed: %s (grid %d)\n", hipGetErrorString(e), grid);
}
```

```cpp
#include <hip/hip_runtime.h>
#include <hip/hip_cooperative_groups.h>
#include <cstdio>
#include <cstdint>
namespace cg = cooperative_groups;
namespace pg8 {
#define PG8_LAS __attribute__((address_space(3)))
typedef unsigned short bf16_t;
typedef short bf16x8 __attribute__((ext_vector_type(8)));
typedef float f32x4 __attribute__((ext_vector_type(4)));
typedef unsigned u32x4 __attribute__((ext_vector_type(4)));
constexpr int BM = 256, BK = 64, HALF = 128, HTB = HALF * BK * 2  , STAGE_BYTES = 8 * HTB, NXCD = 8, WGM = 8;

__host__ __device__ __forceinline__ int lds_byte(int r, int c) { const int st = (r >> 4) * 2 + (c >> 5), rr = r & 15, cc = c & 31, ob = rr * 64 + cc * 2; return st * 1024 + (ob ^ (((ob >> 9) & 1) << 5)); }
__host__ __device__ __forceinline__ void stage_rc(int b, int& R, int& C) { const int st = b / 1024, sb = b % 1024, swz = sb ^ (((sb >> 9) & 1) << 5); R = (st >> 1) * 16 + swz / 64; C = (st & 1) * 32 + (swz % 64) / 2; }
__host__ __device__ __forceinline__ int perm32(int rho) { const int n = rho >> 4, i = rho & 15; return 8 * (i >> 2) + 4 * n + (i & 3); }

struct Unit { int pm, pn; };
struct Gemm { const bf16_t* A; const bf16_t* Bt; int M, N, K; };

struct StaticOrder {
    int nM, nN, nwg, G, c;
    __host__ __device__ void init(int M, int N, int G_, int c_) { nM = M / BM; nN = N / BM; nwg = nM * nN; G = G_; c = c_; }
    __host__ __device__ bool next(int i, Unit& u) const {
        const long L = (long)i * G + c; if (L >= nwg) return false;
        int wgid = (int)L; { const int q = nwg / NXCD, r = nwg % NXCD, xcd = wgid % NXCD, off = wgid / NXCD; wgid = (xcd < r ? xcd * (q + 1) : r * (q + 1) + (xcd - r) * q) + off; }
        const int nig = WGM * nN, gid = wgid / nig, fm = gid * WGM, gsz = (nM - fm) < WGM ? (nM - fm) : WGM;
        u.pm = fm + ((wgid % nig) % gsz); u.pn = (wgid % nig) / gsz; return true;
    }
    __device__ __forceinline__ void a_ready(const Unit&) const {}
    __device__ __forceinline__ void done(const Unit&) const {}
};
struct OrderIn {
    int c;
    __host__ __device__ bool next(int i, Unit& u) const { const int x = c & 7, j = c >> 3; u.pm = 4 * x + (j & 3);
        if (i == 0) { u.pn = j >> 2; return true; } if (i == 1 && j < 24) { u.pn = 8 + (j >> 2); return true; } return false; }
    __device__ __forceinline__ void a_ready(const Unit&) const {}
    __device__ __forceinline__ void done(const Unit&) const {}
};
struct OrderTok {
    int c, npn, nrev;
    __host__ __device__ bool next(int i, Unit& u) const { const int x = c & 7, j = c >> 3; u.pm = 4 * x + (j & 3); const int blk = i < nrev ? nrev - 1 - i : i; u.pn = 8 * blk + (j >> 2); return i >= 0 && u.pn < npn; }
    __device__ __forceinline__ void a_ready(const Unit&) const {}
    __device__ __forceinline__ void done(const Unit&) const {}
};
__device__ __forceinline__ unsigned cvt_pk_bf16(float lo, float hi) { unsigned r; asm volatile("v_cvt_pk_bf16_f32 %0, %1, %2" : "=v"(r) : "v"(lo), "v"(hi)); return r; }
typedef float f32x2 __attribute__((ext_vector_type(2)));
__device__ __forceinline__ f32x2 gelu_pk(f32x2 v) {
    const f32x2 av = __builtin_elementwise_abs(v), d = av * 0.2316418882f + 1.0f;
    f32x2 t; t.x = __builtin_amdgcn_rcpf(d.x); t.y = __builtin_amdgcn_rcpf(d.y);
    f32x2 q = t * 0.5307027145f + (-0.7265760135f); q = q * t + 0.7107068705f; q = q * t + (-0.142248368f); q = q * t + 0.127414796f; q = q * t;
    const f32x2 s = (v * v) * (-0.72134752044f);
    f32x2 e; e.x = __builtin_amdgcn_exp2f(s.x); e.y = __builtin_amdgcn_exp2f(s.y);
    const f32x2 m = v * (q * e), r = v - m;
    f32x2 o; o.x = v.x < 0.f ? m.x : r.x; o.y = v.y < 0.f ? m.y : r.y; return o;
}

__device__ __forceinline__ void store16_wt(void* p, u32x4 v) { asm volatile("global_store_dwordx4 %0, %1, off sc1\n\ts_nop 1" :: "v"(p), "v"(v) : "memory"); }
typedef unsigned long long ss_t;
__device__ __forceinline__ void ss_add(ss_t* p, float sq) { const float fl = floorf(sq); const unsigned hi = (unsigned)fl, lo = (unsigned)((sq - fl) * 4294967296.0f); atomicAdd(p, ((ss_t)hi << 32) | (ss_t)lo); }
__device__ __forceinline__ float ss_get(const ss_t* p) { const ss_t v = *p; return (float)(unsigned)(v >> 32) + (float)(unsigned)v * 2.3283064365386963e-10f; }
typedef unsigned u32x2 __attribute__((ext_vector_type(2)));
__device__ __forceinline__ unsigned pkbf(float lo, float hi) { typedef float f2_t __attribute__((ext_vector_type(2))); typedef __bf16 b2_t __attribute__((ext_vector_type(2))); f2_t v = {lo, hi}; b2_t b = __builtin_convertvector(v, b2_t); return __builtin_bit_cast(unsigned, b); }
struct EpiZ {
    static constexpr bool PERM = true, AFTER_DRAIN = false;
    static constexpr bool KSPLIT = false;
    bf16_t* O; int ldc; int gelu_tiles; const ss_t* ssq;
    __device__ __forceinline__ void operator()(const f32x4 (&acc)[2][2][4][2], const Unit& u, int wr, int wc, int fr, int fq) const {
        int row0 = u.pm * BM + wr * 64 + fr; asm volatile("" : "+v"(row0));     const int col0 = u.pn * BM + wc * 32 + 8 * fq; const bool act = u.pn < gelu_tiles;
#pragma unroll
        for (int ai = 0; ai < 2; ++ai)
#pragma unroll
            for (int m = 0; m < 4; ++m) { const int row = row0 + ai * HALF + m * 16; bf16_t* rowp = O + (size_t)row * ldc + col0;
                const float rs = 1.0f / sqrtf(ss_get(ssq + row) * (1.0f / 2048.f) + 1e-6f);
#pragma unroll
                for (int bj = 0; bj < 2; ++bj) { f32x4 v0 = acc[ai][bj][m][0] * rs, v1 = acc[ai][bj][m][1] * rs;
                    if (act) { f32x2 a = gelu_pk((f32x2){v0[0], v0[1]}), b = gelu_pk((f32x2){v0[2], v0[3]}), c = gelu_pk((f32x2){v1[0], v1[1]}), d = gelu_pk((f32x2){v1[2], v1[3]});
                        v0 = (f32x4){a.x, a.y, b.x, b.y}; v1 = (f32x4){c.x, c.y, d.x, d.y}; }
                    u32x4 w; w.x = pkbf(v0[0], v0[1]); w.y = pkbf(v0[2], v0[3]); w.z = pkbf(v1[0], v1[1]); w.w = pkbf(v1[2], v1[3]);
                    *(u32x4*)(rowp + bj * HALF) = w; } }
    }
};
__device__ __forceinline__ f32x2 swiglu_pk(f32x2 g, f32x2 u, float c1, float rs2) {
    const f32x2 z = g * c1; f32x2 e; e.x = __builtin_amdgcn_exp2f(z.x); e.y = __builtin_amdgcn_exp2f(z.y);
    const f32x2 d = e + 1.0f; f32x2 r; r.x = __builtin_amdgcn_rcpf(d.x); r.y = __builtin_amdgcn_rcpf(d.y);
    return (g * u) * (r * rs2);
}
__device__ __forceinline__ float silu_mul(float g, float u) { const float e = __builtin_amdgcn_exp2f(-1.4426950408889634f * g); return g * __builtin_amdgcn_rcpf(1.0f + e) * u; }
struct EpiSwiGLU {
    static constexpr bool PERM = true, AFTER_DRAIN = false;
    static constexpr bool KSPLIT = false;
    bf16_t* O; int ldc; const ss_t* ssq;
    __device__ __forceinline__ void operator()(const f32x4 (&acc)[2][2][4][2], const Unit& u, int wr, int wc, int fr, int fq) const {
        int row0 = u.pm * BM + wr * 64 + fr; asm volatile("" : "+v"(row0));     const int col0 = u.pn * HALF + wc * 32 + 8 * fq;
#pragma unroll
        for (int ai = 0; ai < 2; ++ai)
#pragma unroll
            for (int m = 0; m < 4; ++m) { const int row = row0 + ai * HALF + m * 16; bf16_t* rowp = O + (size_t)row * ldc + col0;
                const float rs = 1.0f / sqrtf(ss_get(ssq + row) * (1.0f / 2048.f) + 1e-6f);
                const float c1 = -1.4426950408889634f * rs, rs2 = rs * rs;
                const f32x4 ga = acc[ai][0][m][0], gb = acc[ai][0][m][1], ua = acc[ai][1][m][0], ub = acc[ai][1][m][1];
                u32x4 w;
                { const f32x2 o = swiglu_pk((f32x2){ga[0], ga[1]}, (f32x2){ua[0], ua[1]}, c1, rs2); w.x = pkbf(o.x, o.y); }
                { const f32x2 o = swiglu_pk((f32x2){ga[2], ga[3]}, (f32x2){ua[2], ua[3]}, c1, rs2); w.y = pkbf(o.x, o.y); }
                { const f32x2 o = swiglu_pk((f32x2){gb[0], gb[1]}, (f32x2){ub[0], ub[1]}, c1, rs2); w.z = pkbf(o.x, o.y); }
                { const f32x2 o = swiglu_pk((f32x2){gb[2], gb[3]}, (f32x2){ub[2], ub[3]}, c1, rs2); w.w = pkbf(o.x, o.y); }
                *(u32x4*)rowp = w; }
    }
};
template <bool KS> struct EpiResid {
    static constexpr bool PERM = true, AFTER_DRAIN = false, KSPLIT = KS;
    float* OUT; int ldc; bf16_t* XB; ss_t* ssq_out; const ss_t* ssa; const ss_t* ssb;
    __device__ __forceinline__ void mid(f32x4 (&acc)[2][2][4][2], const Unit& u, int wr, int wc, int fr, int fq) const {
        int row0 = u.pm * BM + wr * 64 + fr; asm volatile("" : "+v"(row0));
#pragma unroll
        for (int ai = 0; ai < 2; ++ai)
#pragma unroll
            for (int m = 0; m < 4; ++m) { const int row = row0 + ai * HALF + m * 16;
                const float ra = 1.0f / sqrtf(ss_get(ssa + row) * (1.0f / 1024.f) + 1e-6f), rbi = sqrtf(ss_get(ssb + row) * (1.0f / 1024.f) + 1e-6f); const float ratio = ra * rbi;
#pragma unroll
                for (int bj = 0; bj < 2; ++bj)
#pragma unroll
                    for (int n = 0; n < 2; ++n) acc[ai][bj][m][n] = acc[ai][bj][m][n] * ratio; }
    }
    __device__ __forceinline__ void operator()(const f32x4 (&acc)[2][2][4][2], const Unit& u, int wr, int wc, int fr, int fq) const {
        int row0 = u.pm * BM + wr * 64 + fr; asm volatile("" : "+v"(row0));     const int col0 = u.pn * BM + wc * 32 + 8 * fq;
#pragma unroll
        for (int ai = 0; ai < 2; ++ai) {
            u32x4 res[4][2];
#pragma unroll
            for (int m = 0; m < 4; ++m) { const bf16_t* rowp = XB + (size_t)(row0 + ai * HALF + m * 16) * ldc + col0;
#pragma unroll
                for (int bj = 0; bj < 2; ++bj) res[m][bj] = *(const u32x4*)(rowp + bj * HALF); }
            asm volatile("" ::: "memory");
#pragma unroll
            for (int m = 0; m < 4; ++m) { const int row = row0 + ai * HALF + m * 16; const size_t off = (size_t)row * ldc + col0;
                float rs = 1.0f; if (KS) rs = 1.0f / sqrtf(ss_get(ssb + row) * (1.0f / 1024.f) + 1e-6f);
                float sq = 0.f;
#pragma unroll
                for (int bj = 0; bj < 2; ++bj) { const u32x4 r = res[m][bj];
                    const f32x4 x0 = (f32x4){__uint_as_float(r.x << 16), __uint_as_float(r.x & 0xffff0000u), __uint_as_float(r.y << 16), __uint_as_float(r.y & 0xffff0000u)};
                    const f32x4 x1 = (f32x4){__uint_as_float(r.z << 16), __uint_as_float(r.z & 0xffff0000u), __uint_as_float(r.w << 16), __uint_as_float(r.w & 0xffff0000u)};
                    const f32x4 v0 = x0 + acc[ai][bj][m][0] * rs, v1 = x1 + acc[ai][bj][m][1] * rs;
                    if (OUT) { *(f32x4*)(OUT + off + bj * HALF) = v0; *(f32x4*)(OUT + off + bj * HALF + 4) = v1; }
                    else { sq += ((v0[0] * v0[0] + v0[1] * v0[1]) + (v0[2] * v0[2] + v0[3] * v0[3])) + ((v1[0] * v1[0] + v1[1] * v1[1]) + (v1[2] * v1[2] + v1[3] * v1[3]));
                        u32x4 w; w.x = pkbf(v0[0], v0[1]); w.y = pkbf(v0[2], v0[3]); w.z = pkbf(v1[0], v1[1]); w.w = pkbf(v1[2], v1[3]); *(u32x4*)(XB + off + bj * HALF) = w; } }
                if (!OUT) { sq += __shfl_xor(sq, 16); sq += __shfl_xor(sq, 32); if (fq == 0) ss_add(ssq_out + row, sq); } }
            asm volatile("" ::: "memory");
        }
    }
};
template <class Epi, class Sched, bool ALIGN_EPI = false, bool SP2 = false>
__device__ __forceinline__ void gemm_phase(PG8_LAS unsigned char* lds, const Gemm g, const Sched& S, const Epi& E) {
    int tid_l = threadIdx.x; asm volatile("" : "+v"(tid_l));
    const int tid = tid_l, wid = __builtin_amdgcn_readfirstlane(tid >> 6), lane = tid & 63, wr = wid >> 2, wc = wid & 3, fr = lane & 15, fq = lane >> 4;
    const int K = g.K, nt = K / BK;
    unsigned voffA[2], voffB[2];
#pragma unroll
    for (int i = 0; i < 2; ++i) { int R, C; stage_rc(tid * 16 + i * 8192, R, C); const int Rb = Epi::PERM ? ((R & ~31) + perm32(R & 31)) : R;
        voffA[i] = (unsigned)(R * K + C) * 2u; voffB[i] = (unsigned)(Rb * K + C) * 2u; }
    const size_t kstep = (size_t)(BK * 2);
    const size_t hstep = (size_t)HALF * K * 2;
    const size_t tstep = 2 * hstep;
    const unsigned ldsw = (unsigned)wid * 1024u;
    const int aoff = lds_byte(wr * 64 + fr, fq * 8), boff = lds_byte(wc * 32 + fr, fq * 8);
#define PG8_SA(b, h) (((b) * 2 + (h)) * HTB)
#define PG8_SB(b, h) ((4 + (b) * 2 + (h)) * HTB)
#define PG8_STAGE(bufoff, gbase, voff) do { _Pragma("unroll") for (int _i = 0; _i < 2; ++_i) \
        __builtin_amdgcn_global_load_lds((const unsigned*)((const char*)(gbase) + (voff)[_i]), (PG8_LAS unsigned*)(lds + (bufoff) + ldsw + _i * 8192), 16, 0, 0); } while (0)
#define PG8_LDA(dst, b, h) do { _Pragma("unroll") for (int m = 0; m < 4; ++m) _Pragma("unroll") for (int k = 0; k < 2; ++k) dst[m][k] = *(const PG8_LAS bf16x8*)(lds + PG8_SA(b, h) + aoff + m * 2048 + k * 1024); } while (0)
#define PG8_LDB(dst, b, h) do { _Pragma("unroll") for (int n = 0; n < 2; ++n) _Pragma("unroll") for (int k = 0; k < 2; ++k) dst[n][k] = *(const PG8_LAS bf16x8*)(lds + PG8_SB(b, h) + boff + n * 2048 + k * 1024); } while (0)
#define PG8_MMA(ai, bj, At, Bt) do { __builtin_amdgcn_s_setprio(1); _Pragma("unroll") for (int m = 0; m < 4; ++m) _Pragma("unroll") for (int n = 0; n < 2; ++n) _Pragma("unroll") for (int k = 0; k < 2; ++k) \
        acc[ai][bj][m][n] = __builtin_amdgcn_mfma_f32_16x16x32_bf16(Bt[n][k], At[m][k], acc[ai][bj][m][n], 0, 0, 0); __builtin_amdgcn_s_setprio(0); } while (0)
#define PG8_WAIT_V(n) asm volatile("s_waitcnt vmcnt(" #n ")" ::: "memory")
#define PG8_WAIT_L(n) asm volatile("s_waitcnt lgkmcnt(" #n ")" ::: "memory")
#define PG8_BAR __builtin_amdgcn_s_barrier()
#define PG8_SCHED __builtin_amdgcn_sched_barrier(0)
    Unit cur, nxt; int ui = 0;
    if (!S.next(0, cur)) return;
    f32x4 acc[2][2][4][2];
#pragma unroll
    for (int a = 0; a < 2; ++a)
#pragma unroll
        for (int b = 0; b < 2; ++b)
#pragma unroll
            for (int m = 0; m < 4; ++m)
#pragma unroll
                for (int n = 0; n < 2; ++n) acc[a][b][m][n] = (f32x4){0.f, 0.f, 0.f, 0.f};
    bf16x8 At[4][2], B0[2][2], B1[2][2];
    const char* cA = (const char*)g.A + (size_t)cur.pm * tstep; const char* cB = (const char*)g.Bt + (size_t)cur.pn * tstep;
    S.a_ready(cur);
    if constexpr (SP2) {
        PG8_STAGE(PG8_SB(0, 0), cB, voffB); PG8_STAGE(PG8_SB(0, 1), cB + hstep, voffB); PG8_STAGE(PG8_SA(0, 0), cA, voffA); PG8_STAGE(PG8_SA(0, 1), cA + hstep, voffA);
        if (wr == 1) PG8_BAR;
        PG8_WAIT_V(2); PG8_BAR;
        PG8_STAGE(PG8_SB(1, 0), cB + kstep, voffB); PG8_STAGE(PG8_SA(1, 0), cA + kstep, voffA); PG8_STAGE(PG8_SB(1, 1), cB + hstep + kstep, voffB);
        PG8_WAIT_V(6); PG8_BAR;
    } else {
        PG8_STAGE(PG8_SB(0, 0), cB, voffB); PG8_STAGE(PG8_SA(0, 0), cA, voffA); PG8_STAGE(PG8_SB(0, 1), cB + hstep, voffB); PG8_STAGE(PG8_SA(0, 1), cA + hstep, voffA);
        if (wr == 1) PG8_BAR;
        PG8_WAIT_V(4); PG8_BAR;
        PG8_STAGE(PG8_SB(1, 0), cB + kstep, voffB); PG8_STAGE(PG8_SA(1, 0), cA + kstep, voffA); PG8_STAGE(PG8_SB(1, 1), cB + hstep + kstep, voffB);
        PG8_WAIT_V(6); PG8_BAR;
    }
    for (;;) {
        const bool has_next = S.next(ui + 1, nxt);
        const char* nA = has_next ? (const char*)g.A + (size_t)nxt.pm * tstep : cA; const char* nB = has_next ? (const char*)g.Bt + (size_t)nxt.pn * tstep : cB;
        for (int t = 0; t < nt; t += 2) {
            const bool last = (t == nt - 2);
            const char* a1 = cA + (size_t)(t + 1) * kstep;
            const char* a2 = last ? nA : cA + (size_t)(t + 2) * kstep; const char* b2 = last ? nB : cB + (size_t)(t + 2) * kstep;
            const char* a3 = a2 + kstep; const char* b3 = b2 + kstep;
            if (last && has_next) S.a_ready(nxt);
            if constexpr (Epi::KSPLIT) { if (t == (nt >> 1)) E.mid(acc, cur, wr, wc, fr, fq); }
            if constexpr (SP2) {
            PG8_LDB(B0, 0, 0); PG8_LDB(B1, 0, 1); PG8_SCHED; PG8_LDA(At, 0, 0); PG8_STAGE(PG8_SA(1, 1), a1 + hstep, voffA);
            PG8_WAIT_V(8); PG8_WAIT_L(0); PG8_BAR; PG8_MMA(0, 0, At, B0); PG8_MMA(0, 1, At, B1); PG8_BAR; PG8_SCHED;
            PG8_LDA(At, 0, 1); PG8_STAGE(PG8_SB(0, 0), b2, voffB); PG8_STAGE(PG8_SB(0, 1), b2 + hstep, voffB); PG8_STAGE(PG8_SA(0, 0), a2, voffA);
            PG8_WAIT_V(8); PG8_WAIT_L(0); PG8_BAR; PG8_MMA(1, 0, At, B0); PG8_MMA(1, 1, At, B1); PG8_BAR; PG8_SCHED;
            PG8_LDB(B0, 1, 0); PG8_LDB(B1, 1, 1); PG8_SCHED; PG8_LDA(At, 1, 0); PG8_STAGE(PG8_SA(0, 1), a2 + hstep, voffA);
            PG8_WAIT_V(8); PG8_WAIT_L(0); PG8_BAR; PG8_MMA(0, 0, At, B0); PG8_MMA(0, 1, At, B1); PG8_BAR; PG8_SCHED;
            PG8_LDA(At, 1, 1); PG8_STAGE(PG8_SB(1, 0), b3, voffB); PG8_STAGE(PG8_SB(1, 1), b3 + hstep, voffB); PG8_STAGE(PG8_SA(1, 0), a3, voffA);
            PG8_WAIT_V(8); PG8_WAIT_L(0); PG8_BAR; PG8_MMA(1, 0, At, B0); PG8_MMA(1, 1, At, B1); PG8_BAR; PG8_SCHED;
            } else {
            PG8_LDB(B0, 0, 0); PG8_SCHED; PG8_LDA(At, 0, 0); PG8_STAGE(PG8_SA(1, 1), a1 + hstep, voffA);
            PG8_WAIT_L(8); PG8_BAR; PG8_WAIT_L(0); PG8_MMA(0, 0, At, B0); PG8_BAR; PG8_SCHED;
            PG8_LDB(B1, 0, 1); PG8_STAGE(PG8_SB(0, 0), b2, voffB);
            PG8_BAR; PG8_WAIT_L(0); PG8_MMA(0, 1, At, B1); PG8_BAR;
            PG8_LDA(At, 0, 1); PG8_STAGE(PG8_SA(0, 0), a2, voffA);
            PG8_BAR; PG8_WAIT_L(0); PG8_MMA(1, 0, At, B0); PG8_BAR; PG8_SCHED;
            PG8_STAGE(PG8_SB(0, 1), b2 + hstep, voffB);
            PG8_WAIT_V(6); PG8_BAR; PG8_MMA(1, 1, At, B1); PG8_BAR;
            PG8_LDB(B0, 1, 0); PG8_SCHED; PG8_LDA(At, 1, 0); PG8_STAGE(PG8_SA(0, 1), a2 + hstep, voffA);
            PG8_WAIT_L(8); PG8_BAR; PG8_WAIT_L(0); PG8_MMA(0, 0, At, B0); PG8_BAR; PG8_SCHED;
            PG8_LDB(B1, 1, 1); PG8_STAGE(PG8_SB(1, 0), b3, voffB);
            PG8_BAR; PG8_WAIT_L(0); PG8_MMA(0, 1, At, B1); PG8_BAR;
            PG8_LDA(At, 1, 1); PG8_STAGE(PG8_SA(1, 0), a3, voffA);
            PG8_BAR; PG8_WAIT_L(0); PG8_MMA(1, 0, At, B0); PG8_BAR; PG8_SCHED;
            PG8_STAGE(PG8_SB(1, 1), b3 + hstep, voffB);
            PG8_WAIT_V(6); PG8_BAR; PG8_MMA(1, 1, At, B1); PG8_BAR;
            }
        }
        if constexpr (ALIGN_EPI) { if (wr == 0) PG8_BAR; }
        if constexpr (!Epi::AFTER_DRAIN) { E(acc, cur, wr, wc, fr, fq); S.done(cur); }
        if (!has_next) break;
#pragma unroll
        for (int a = 0; a < 2; ++a)
#pragma unroll
            for (int b = 0; b < 2; ++b)
#pragma unroll
                for (int m = 0; m < 4; ++m)
#pragma unroll
                    for (int n = 0; n < 2; ++n) acc[a][b][m][n] = (f32x4){0.f, 0.f, 0.f, 0.f};
        cur = nxt; cA = nA; cB = nB; ++ui;
        if constexpr (ALIGN_EPI) { if (wr == 1) PG8_BAR; }
    }
    PG8_WAIT_V(0);
    if constexpr (!ALIGN_EPI) { if (wr == 0) PG8_BAR; }
    PG8_BAR;
    if constexpr (Epi::AFTER_DRAIN) { E.fused(acc, cur, wr, wc, fr, fq, lds, wid, lane); S.done(cur); }
#undef PG8_SA
#undef PG8_SB
#undef PG8_STAGE
#undef PG8_LDA
#undef PG8_LDB
#undef PG8_MMA
#undef PG8_WAIT_V
#undef PG8_WAIT_L
#undef PG8_BAR
#undef PG8_SCHED
}
}
constexpr int SEQ = 8192, DM = 2048, INW = 3584, DFF = 5632, DEPTH = 4, NGU = 2 * DFF;
constexpr int QCOL = 2048, KCOL = 3072, VCOL = 3328;
constexpr float EPS = 1e-6f;
constexpr size_t MiB = 1u << 20;
constexpr size_t WS_CTL = 0;
constexpr size_t WS_WIN = 2 * MiB,               SZ_WIN = (size_t)INW * DM * 2;
constexpr size_t WS_WOUT = WS_WIN + 4 * SZ_WIN,  SZ_WOUT = (size_t)DM * DM * 2;
constexpr size_t WS_WGU = WS_WOUT + 4 * SZ_WOUT, SZ_WGU = (size_t)NGU * DM * 2;
constexpr size_t WS_WDN = WS_WGU + 4 * SZ_WGU,   SZ_WDN = (size_t)DM * DFF * 2;
constexpr size_t WS_XN = WS_WDN + 4 * SZ_WDN;
constexpr size_t WS_Z = WS_XN + (size_t)SEQ * DM * 2;
constexpr size_t WS_MIX = WS_Z + (size_t)SEQ * INW * 2;
constexpr size_t WS_ACT = WS_MIX + (size_t)SEQ * DM * 2;
constexpr size_t WS_END = WS_ACT + (size_t)SEQ * DFF * 2;
constexpr size_t WS_SS = 65536;
constexpr int SS_Q1 = 0, SS_Q2 = 4, SS_A = 8, SS_B = 12;
constexpr size_t CTL_ZERO_BYTES = WS_SS + 16 * (size_t)SEQ * 8;
constexpr int LDS_BYTES = 147456;
constexpr int NWAVES = 8;

typedef unsigned short bf16;
typedef float f32x4 __attribute__((ext_vector_type(4)));
typedef short bf16x8 __attribute__((ext_vector_type(8)));
typedef unsigned u32x4 __attribute__((ext_vector_type(4)));
typedef unsigned u32x2 __attribute__((ext_vector_type(2)));
using pg8::pkbf; using pg8::ss_t; using pg8::ss_add; using pg8::ss_get;
__device__ __forceinline__ float bflo(unsigned w) { return __uint_as_float(w << 16); }
__device__ __forceinline__ float bfhi(unsigned w) { return __uint_as_float(w & 0xffff0000u); }
__device__ __forceinline__ float wave_sum(float v) {
#pragma unroll
    for (int o = 1; o < 64; o <<= 1) v += __shfl_xor(v, o);
    return v;
}

struct Args {
    const float *x, *rel_bias, *norm1_g, *w_in, *sgu_norm_g, *sgu_w, *sgu_b, *q_norm_g, *k_norm_g, *sinks, *out_norm_a, *out_norm_b, *w_out, *norm2_g, *w_gate, *w_up, *w_down;
    float* out; unsigned char* ws;
    int never, pad;
};

constexpr int TSCR = 64 * 65 * 4;
__device__ __forceinline__ void transpose_item(const float* W, int K, int N, bf16* WT, int k0, int n0, int dst_row0, const float* gain_k0, float* scr, int lane) {
    const int r = lane >> 4, q = lane & 15;
    const float* src = W + (size_t)(k0 + r) * N + n0 + 4 * q;
    f32x4 v[16];
#pragma unroll
    for (int i = 0; i < 16; ++i) v[i] = __builtin_nontemporal_load((const f32x4*)(src + (size_t)(4 * i) * N));
#pragma unroll
    for (int i = 0; i < 16; ++i) { float* d = scr + (4 * i + r) * 65 + 4 * q; d[0] = v[i].x; d[1] = v[i].y; d[2] = v[i].z; d[3] = v[i].w; }
    asm volatile("s_waitcnt lgkmcnt(0)" ::: "memory");
    const int c = lane & 7;
    f32x4 g0 = (f32x4){1.f, 1.f, 1.f, 1.f}, g1 = g0;
    if (gain_k0) { g0 = *(const f32x4*)(gain_k0 + 8 * c); g1 = *(const f32x4*)(gain_k0 + 8 * c + 4); }
#pragma unroll
    for (int j = 0; j < 8; ++j) { const int n = (lane >> 3) + 8 * j; const float* s = scr + (8 * c) * 65 + n;
        u32x4 o; o.x = pkbf(s[0 * 65] * g0.x, s[1 * 65] * g0.y); o.y = pkbf(s[2 * 65] * g0.z, s[3 * 65] * g0.w); o.z = pkbf(s[4 * 65] * g1.x, s[5 * 65] * g1.y); o.w = pkbf(s[6 * 65] * g1.z, s[7 * 65] * g1.w);
        *(u32x4*)(WT + (size_t)(dst_row0 + n) * K + k0 + 8 * c) = o; }
    asm volatile("s_waitcnt lgkmcnt(0)" ::: "memory");
}
__device__ __forceinline__ void prologue_rows(const float* X, bf16* XB, ss_t* ssq, int gw, int NGW, int lane) {
    for (int m = gw; m < SEQ; m += NGW) {
        const f32x4* xr = (const f32x4*)(X + (size_t)m * DM) + lane;
        f32x4 v[8]; float ss = 0.f;
#pragma unroll
        for (int j = 0; j < 8; ++j) { v[j] = xr[64 * j]; ss += (v[j].x * v[j].x + v[j].y * v[j].y) + (v[j].z * v[j].z + v[j].w * v[j].w); }
        ss = wave_sum(ss); if (lane == 0) { const float fl = floorf(ss); ssq[m] = ((ss_t)(unsigned)fl << 32) | (ss_t)(unsigned)((ss - fl) * 4294967296.0f); }
        u32x2* o = (u32x2*)(XB + (size_t)m * DM) + lane;
#pragma unroll
        for (int j = 0; j < 8; ++j) { u32x2 w; w.x = pkbf(v[j].x, v[j].y); w.y = pkbf(v[j].z, v[j].w); o[64 * j] = w; }
    }
}
#define LAS __attribute__((address_space(3)))
#define XB_TMO      128
#define XB_XCNT(j)  (256  + 64 * (j))
#define XB_XSUB(j)  (1280 + 64 * (j))
#define XB_XGEN(j)  (2304 + 64 * (j))
#define XB_TOP      3328
#define XB_TOPGEN   3392
#define XCD_BAR_WORDS 3456
#define XB_SPIN_CAP (1u << 18)

__device__ __forceinline__ unsigned xb_ld(unsigned* p)              { return __hip_atomic_load(p, __ATOMIC_RELAXED, __HIP_MEMORY_SCOPE_AGENT); }
__device__ __forceinline__ unsigned xb_add(unsigned* p, unsigned v) { return __hip_atomic_fetch_add(p, v, __ATOMIC_RELAXED, __HIP_MEMORY_SCOPE_AGENT); }
__device__ __forceinline__ unsigned xb_xcc_id() { return (unsigned)__builtin_amdgcn_s_getreg((3 << 11) | 20) & 0xFu; }
#define XB_SPIN(cond, bar) do { unsigned _sp = 0; while (cond) { __builtin_amdgcn_s_sleep(1); \
    if ((++_sp & 255u) == 0u) { if (xb_ld(&(bar)[XB_TMO])) break; if (_sp > XB_SPIN_CAP) { atomicAdd(&(bar)[XB_TMO], 1u); break; } } } } while (0)

struct XcdBarrier {
    unsigned* bar; unsigned x;
    volatile LAS unsigned* st;
};

__device__ __forceinline__ XcdBarrier xcd_barrier_post(unsigned* bar, volatile LAS unsigned* st) {
    XcdBarrier b; b.bar = bar; b.x = xb_xcc_id(); b.st = st;
    if (threadIdx.x == 0) (void)xb_add(&bar[XB_XCNT(b.x)], 1u);
    return b;
}
__device__ __forceinline__ void xcd_barrier_complete(unsigned* bar, unsigned x, unsigned& nloc, unsigned& nx) {
    const unsigned G = gridDim.x * gridDim.y * gridDim.z;
    unsigned sum, cnt, mine, sp = 0u;
    for (;;) {
        sum = 0u; cnt = 0u; mine = 0u;
#pragma unroll
        for (unsigned j = 0; j < 16; ++j) { const unsigned c = xb_ld(&bar[XB_XCNT(j)]); sum += c; cnt += (c > 0u) ? 1u : 0u; mine = (j == x) ? c : mine; }
        if (sum == G) break;
        __builtin_amdgcn_s_sleep(1);
        if ((++sp & 255u) == 0u) { if (xb_ld(&bar[XB_TMO])) break; if (sp > XB_SPIN_CAP) { atomicAdd(&bar[XB_TMO], 1u); break; } }
    }
    nloc = mine > 0u ? mine : 1u; nx = cnt > 0u ? cnt : 1u;
}

__device__ __forceinline__ void xcd_barrier(const XcdBarrier& b) {
    asm volatile("s_waitcnt vmcnt(0)" ::: "memory");
    __syncthreads();
    if (threadIdx.x == 0) {
        unsigned* bar = b.bar;
        __builtin_amdgcn_s_waitcnt(0);
        unsigned nloc = b.st[0], nx = b.st[1];
        if (nloc == 0u) { xcd_barrier_complete(bar, b.x, nloc, nx); b.st[0] = nloc; b.st[1] = nx; }
        const unsigned old = xb_add(&bar[XB_XSUB(b.x)], 1u);
        const unsigned gen = old / nloc;
        if (old + 1u == (gen + 1u) * nloc) {
            __builtin_amdgcn_fence(__ATOMIC_RELEASE, "agent");
            asm volatile("s_waitcnt vmcnt(0)" ::: "memory");
            const unsigned og = xb_add(&bar[XB_TOP], 1u);
            const unsigned tg = og / nx;
            if (og + 1u == (tg + 1u) * nx) xb_add(&bar[XB_TOPGEN], 1u);
            else XB_SPIN(xb_ld(&bar[XB_TOPGEN]) == tg, bar);
            __builtin_amdgcn_fence(__ATOMIC_ACQUIRE, "agent");
            xb_add(&bar[XB_XGEN(b.x)], 1u);
            asm volatile("s_waitcnt vmcnt(0)" ::: "memory");
        } else {
            XB_SPIN(xb_ld(&bar[XB_XGEN(b.x)]) == gen, bar);
            __builtin_amdgcn_fence(__ATOMIC_ACQUIRE, "agent");
            asm volatile("s_waitcnt vmcnt(0)" ::: "memory");
        }
    }
    __syncthreads();
}

#define LB_SUB(j) (4096 + 64 * (j))
#define LB_GEN(j) (5120 + 64 * (j))
__device__ __forceinline__ void xcc_local_barrier(unsigned* bar, unsigned x, unsigned nloc) {
    asm volatile("s_waitcnt vmcnt(0)" ::: "memory");
    __syncthreads();
    if (threadIdx.x == 0) {
        __builtin_amdgcn_s_waitcnt(0);
        const unsigned old = xb_add(&bar[LB_SUB(x)], 1u);
        const unsigned gen = old / nloc;
        if (old + 1u == (gen + 1u) * nloc) xb_add(&bar[LB_GEN(x)], 1u);
        else XB_SPIN(xb_ld(&bar[LB_GEN(x)]) == gen, bar);
        __builtin_amdgcn_fence(__ATOMIC_ACQUIRE, "agent");
        asm volatile("s_waitcnt vmcnt(0)" ::: "memory");
    }
    __syncthreads();
}
constexpr int KS_STRIDE = 72;
constexpr int VT_STRIDE = 264;
constexpr int LDS_KS = 0, LDS_VT = 256 * KS_STRIDE * 2, LDS_BT = LDS_VT + 64 * VT_STRIDE * 2;
constexpr int VN_STRIDE = 136;
#define MFMA16(a, b, c) __builtin_amdgcn_mfma_f32_16x16x32_bf16((a), (b), (c), 0, 0, 0)

__device__ __forceinline__ int t5_bucket(int n) {
    if (n < 16) return n;
    const float v = logf((float)n / 16.0f) / 2.0794415416798357f * 16.0f;
    int b = 16 + (int)v; return b < 31 ? b : 31;
}

__device__ __forceinline__ void attn_load_q(u32x4 (&q0)[2], const bf16* Z, int n, int kvh, int wid, int lane) {
    const int g = wid >> 1, qh = wid & 1, hq = kvh * 4 + g, fr = lane & 15, fq = lane >> 4;
    const bf16* qp = Z + (size_t)(n * 128 + 64 * qh + fr) * INW + QCOL + hq * 64; q0[0] = *(const u32x4*)(qp + 8 * fq); q0[1] = *(const u32x4*)(qp + 32 + 8 * fq);
}
template <int PAR> __device__ __forceinline__ void attn_sub(const bf16* KS, const bf16* VT, const float* BTg, const float* gq, float sink2, int n, int ti, int hq, const u32x4 w0, const u32x4 w1, bf16* MIX, ss_t* ssb, int lane) {
    const int fr = lane & 15, fq = lane >> 4; const int qi = 16 * ti + fr, tb = ti - PAR; const int tok = n * 128 + qi;
    bf16x8 qf[2];
    { float f0[8], f1[8]; float ss = 0.f;
#pragma unroll
      for (int e = 0; e < 4; ++e) { f0[2 * e] = bflo(w0[e]); f0[2 * e + 1] = bfhi(w0[e]); f1[2 * e] = bflo(w1[e]); f1[2 * e + 1] = bfhi(w1[e]);
          ss += (f0[2 * e] * f0[2 * e] + f0[2 * e + 1] * f0[2 * e + 1]) + (f1[2 * e] * f1[2 * e] + f1[2 * e + 1] * f1[2 * e + 1]); }
      ss += __shfl_xor(ss, 16); ss += __shfl_xor(ss, 32);
      const float rs = (0.125f * 1.4426950408889634f) / sqrtf(ss * (1.0f / 64.f) + EPS);
      const f32x4 a0 = *(const f32x4*)(gq + 8 * fq), a1 = *(const f32x4*)(gq + 8 * fq + 4), b0 = *(const f32x4*)(gq + 32 + 8 * fq), b1 = *(const f32x4*)(gq + 32 + 8 * fq + 4);
      u32x4 p0, p1;
      p0.x = pkbf(f0[0] * rs * a0.x, f0[1] * rs * a0.y); p0.y = pkbf(f0[2] * rs * a0.z, f0[3] * rs * a0.w); p0.z = pkbf(f0[4] * rs * a1.x, f0[5] * rs * a1.y); p0.w = pkbf(f0[6] * rs * a1.z, f0[7] * rs * a1.w);
      p1.x = pkbf(f1[0] * rs * b0.x, f1[1] * rs * b0.y); p1.y = pkbf(f1[2] * rs * b0.z, f1[3] * rs * b0.w); p1.z = pkbf(f1[4] * rs * b1.x, f1[5] * rs * b1.y); p1.w = pkbf(f1[6] * rs * b1.z, f1[7] * rs * b1.w);
      qf[0] = __builtin_bit_cast(bf16x8, p0); qf[1] = __builtin_bit_cast(bf16x8, p1); }
    const int e0 = 4 * fq - fr;
    const float* bp = BTg + (128 - 16 * 8 - 3 - e0);
    f32x4 sc[10]; float mx = sink2;
#pragma unroll
    for (int t = 0; t < 10; ++t) {
        constexpr int dummy = 0; (void)dummy;
        const int rel = t - PAR;
        if (rel < 0 || rel > 8) { sc[t] = (f32x4){0.f, 0.f, 0.f, 0.f}; continue; }
        const bf16* kp = KS + (16 * (tb + t) + fr) * KS_STRIDE + 8 * fq;
        const bf16x8 k0 = *(const bf16x8*)kp, k1 = *(const bf16x8*)(kp + 32);
        f32x4 acc = (f32x4){0.f, 0.f, 0.f, 0.f};
        acc = MFMA16(k0, qf[0], acc); acc = MFMA16(k1, qf[1], acc);
        const bool tv = (n > 0) || (tb + t >= 8);
#pragma unroll
        for (int r = 0; r < 4; ++r) { bool valid = tv; if (rel == 0) valid = valid && (e0 + r >= 1); if (rel == 8) valid = valid && (e0 + r <= 0);
            const float v = valid ? acc[r] + bp[16 * (8 - rel) + (3 - r)] : -1e30f; acc[r] = v; mx = fmaxf(mx, v); }
        sc[t] = acc;
    }
    mx = fmaxf(mx, __shfl_xor(mx, 16)); mx = fmaxf(mx, __shfl_xor(mx, 32));
    float lsum = 0.f;
#pragma unroll
    for (int t = 0; t < 10; ++t) { const int rel = t - PAR; if (rel < 0 || rel > 8) continue;
#pragma unroll
        for (int r = 0; r < 4; ++r) { const float p = __builtin_amdgcn_exp2f(sc[t][r] - mx); sc[t][r] = p; lsum += p; } }
    lsum += __shfl_xor(lsum, 16); lsum += __shfl_xor(lsum, 32);
    lsum += __builtin_amdgcn_exp2f(sink2 - mx);
    const float rl = 1.0f / lsum;
    f32x4 o[4];
#pragma unroll
    for (int dt = 0; dt < 4; ++dt) o[dt] = (f32x4){0.f, 0.f, 0.f, 0.f};
#pragma unroll
    for (int p = 0; p < 5; ++p) {
        u32x4 pw; pw.x = pkbf(sc[2 * p][0], sc[2 * p][1]); pw.y = pkbf(sc[2 * p][2], sc[2 * p][3]); pw.z = pkbf(sc[2 * p + 1][0], sc[2 * p + 1][1]); pw.w = pkbf(sc[2 * p + 1][2], sc[2 * p + 1][3]);
        const bf16x8 pb = __builtin_bit_cast(bf16x8, pw);
#pragma unroll
        for (int dt = 0; dt < 4; ++dt) {
            const bf16* vp = VT + (16 * dt + fr) * VT_STRIDE + 16 * (tb + 2 * p) + 4 * fq;
            const u32x2 lo = *(const u32x2*)vp, hi = *(const u32x2*)(vp + 16);
            const u32x4 va = (u32x4){lo.x, lo.y, hi.x, hi.y};
            o[dt] = MFMA16(__builtin_bit_cast(bf16x8, va), pb, o[dt]);
        }
    }
    bf16* op = MIX + (size_t)tok * DM + 1024 + hq * 64 + 4 * fq;
    float sq = 0.f;
#pragma unroll
    for (int dt = 0; dt < 4; ++dt) { const f32x4 v = o[dt] * rl; sq += (v[0] * v[0] + v[1] * v[1]) + (v[2] * v[2] + v[3] * v[3]); u32x2 w; w.x = pkbf(v[0], v[1]); w.y = pkbf(v[2], v[3]); *(u32x2*)(op + 16 * dt) = w; }
    sq += __shfl_xor(sq, 16); sq += __shfl_xor(sq, 32); if (fq == 0) ss_add(ssb + tok, sq);
}
__device__ __forceinline__ void attn_compute(const Args& A, int l, int n, int kvh, const u32x4 (&q0)[2], const bf16* Z, bf16* MIX, ss_t* ssb, unsigned char* lds, int wid, int lane) {
    const bf16* KS = (const bf16*)(lds + LDS_KS); const bf16* VT = (const bf16*)(lds + LDS_VT); const float* BT = (const float*)(lds + LDS_BT);
    const float* gq = A.q_norm_g + l * 64;
    const int g = wid >> 1, qh = wid & 1, hq = kvh * 4 + g; const int fr = lane & 15, fq = lane >> 4;
    const float sink2 = A.sinks[l * 16 + hq] * 1.4426950408889634f;
    const float* BTg = BT + g * 128;
    u32x4 qc0 = q0[0], qc1 = q0[1];
#pragma nounroll
    for (int ip = 0; ip < 2; ++ip) {
        const int ti = 4 * qh + 2 * ip;
        const bf16* qp = Z + (size_t)(n * 128 + 16 * ti + fr) * INW + QCOL + hq * 64;
        u32x4 w0 = qc0, w1 = qc1;
        qc0 = *(const u32x4*)(qp + (size_t)16 * INW + 8 * fq); qc1 = *(const u32x4*)(qp + (size_t)16 * INW + 32 + 8 * fq);
        attn_sub<0>(KS, VT, BTg, gq, sink2, n, ti, hq, w0, w1, MIX, ssb, lane);
        w0 = qc0; w1 = qc1;
        if (ip == 0) { qc0 = *(const u32x4*)(qp + (size_t)32 * INW + 8 * fq); qc1 = *(const u32x4*)(qp + (size_t)32 * INW + 32 + 8 * fq); }
        attn_sub<1>(KS, VT, BTg, gq, sink2, n, ti + 1, hq, w0, w1, MIX, ssb, lane);
    }
}

__device__ __forceinline__ void attn_unit(const Args& A, int l, int n, int kvh, const bf16* Z, bf16* MIX, ss_t* ssb, unsigned char* lds, int tid, int wid, int lane) {
    bf16* KS = (bf16*)(lds + LDS_KS); bf16* VT = (bf16*)(lds + LDS_VT); float* BT = (float*)(lds + LDS_BT);
    const float* gk = A.k_norm_g + l * 64; const float* gq = A.q_norm_g + l * 64;
#pragma unroll
    for (int i = 0; i < 4; ++i) {
        const int id = tid + 512 * i, row = id >> 3, ch = id & 7; const int tok = (n - 1) * 128 + row;
        u32x4 kw = (u32x4){0u, 0u, 0u, 0u}, vw = (u32x4){0u, 0u, 0u, 0u};
        if (tok >= 0) { const bf16* zr = Z + (size_t)tok * INW; kw = *(const u32x4*)(zr + KCOL + kvh * 64 + ch * 8); vw = *(const u32x4*)(zr + VCOL + kvh * 64 + ch * 8); }
        float f[8]; float ss = 0.f;
#pragma unroll
        for (int e = 0; e < 4; ++e) { f[2 * e] = bflo(kw[e]); f[2 * e + 1] = bfhi(kw[e]); ss += f[2 * e] * f[2 * e] + f[2 * e + 1] * f[2 * e + 1]; }
        ss += __shfl_xor(ss, 1); ss += __shfl_xor(ss, 2); ss += __shfl_xor(ss, 4);
        const float rstd = 1.0f / sqrtf(ss * (1.0f / 64.f) + EPS);
        const f32x4 g0 = *(const f32x4*)(gk + ch * 8), g1 = *(const f32x4*)(gk + ch * 8 + 4);
        u32x4 o; o.x = pkbf(f[0] * rstd * g0.x, f[1] * rstd * g0.y); o.y = pkbf(f[2] * rstd * g0.z, f[3] * rstd * g0.w); o.z = pkbf(f[4] * rstd * g1.x, f[5] * rstd * g1.y); o.w = pkbf(f[6] * rstd * g1.z, f[7] * rstd * g1.w);
        *(u32x4*)(KS + row * KS_STRIDE + ch * 8) = o;
#pragma unroll
        for (int e = 0; e < 4; ++e) { VT[(ch * 8 + 2 * e) * VT_STRIDE + row] = (bf16)(vw[e] & 0xffffu); VT[(ch * 8 + 2 * e + 1) * VT_STRIDE + row] = (bf16)(vw[e] >> 16); }
    }
    { const int g = tid >> 7, dist = tid & 127; BT[g * 128 + dist] = A.rel_bias[t5_bucket(dist) * 16 + kvh * 4 + g] * 1.4426950408889634f; }
    __syncthreads();
    { u32x4 q0[2]; attn_load_q(q0, Z, n, kvh, wid, lane); attn_compute(A, l, n, kvh, q0, Z, MIX, ssb, lds, wid, lane); }
    __syncthreads();
}

__device__ __forceinline__ void sgu_unit(const Args& A, int l, int c, int h, const bf16* Z, bf16* MIX, ss_t* ssa, unsigned char* lds, int tid, int wid, int lane) {
    bf16* VN = (bf16*)lds;
    const float* gs = A.sgu_norm_g + (l * 16 + h) * 64;
#pragma unroll
    for (int i = 0; i < 2; ++i) {
        const int id = tid + 512 * i, row = id >> 3, ch = id & 7;
        const u32x4 vw = *(const u32x4*)(Z + (size_t)(c * 128 + row) * INW + 1024 + h * 64 + ch * 8);
        float f[8]; float ss = 0.f;
#pragma unroll
        for (int e = 0; e < 4; ++e) { f[2 * e] = bflo(vw[e]); f[2 * e + 1] = bfhi(vw[e]); ss += f[2 * e] * f[2 * e] + f[2 * e + 1] * f[2 * e + 1]; }
        ss += __shfl_xor(ss, 1); ss += __shfl_xor(ss, 2); ss += __shfl_xor(ss, 4);
        const float rstd = 1.0f / sqrtf(ss * (1.0f / 64.f) + EPS);
#pragma unroll
        for (int e = 0; e < 8; e += 2) { const unsigned w = pkbf(f[e] * rstd * gs[ch * 8 + e], f[e + 1] * rstd * gs[ch * 8 + e + 1]);
            VN[(ch * 8 + e) * VN_STRIDE + row] = (bf16)(w & 0xffffu); VN[(ch * 8 + e + 1) * VN_STRIDE + row] = (bf16)(w >> 16); }
    }
    __syncthreads();
    const int fr = lane & 15, fq = lane >> 4; const int t = 16 * wid + fr; const int nks = (wid >> 1) + 1;
    const float* wrow = A.sgu_w + ((size_t)(l * 16 + h) * 128 + t) * 128;
    bf16x8 bfr[4];
#pragma unroll
    for (int ks = 0; ks < 4; ++ks) {
        u32x4 w = (u32x4){0u, 0u, 0u, 0u};
        if (ks < nks) { const int s0 = 32 * ks + 8 * fq; const f32x4 a = *(const f32x4*)(wrow + s0), b = *(const f32x4*)(wrow + s0 + 4);
            float f[8] = {a.x, a.y, a.z, a.w, b.x, b.y, b.z, b.w};
#pragma unroll
            for (int e = 0; e < 8; ++e) f[e] = (s0 + e <= t) ? f[e] : 0.f;
            w.x = pkbf(f[0], f[1]); w.y = pkbf(f[2], f[3]); w.z = pkbf(f[4], f[5]); w.w = pkbf(f[6], f[7]); }
        bfr[ks] = __builtin_bit_cast(bf16x8, w);
    }
    const float bias = A.sgu_b[(l * 16 + h) * 128 + t];
    const size_t tok = (size_t)(c * 128 + t); float sq = 0.f;
#pragma unroll
    for (int dt = 0; dt < 4; ++dt) {
        f32x4 acc = (f32x4){0.f, 0.f, 0.f, 0.f};
#pragma unroll
        for (int ks = 0; ks < 4; ++ks) if (ks < nks) { const bf16x8 a = *(const bf16x8*)(VN + (16 * dt + fr) * VN_STRIDE + 32 * ks + 8 * fq); acc = MFMA16(a, bfr[ks], acc); }
        const int d0 = h * 64 + 16 * dt + 4 * fq;
        const u32x2 uw = *(const u32x2*)(Z + tok * INW + d0);
        const float v0 = bflo(uw.x) * (acc[0] + bias), v1 = bfhi(uw.x) * (acc[1] + bias), v2 = bflo(uw.y) * (acc[2] + bias), v3 = bfhi(uw.y) * (acc[3] + bias);
        sq += (v0 * v0 + v1 * v1) + (v2 * v2 + v3 * v3);
        u32x2 w; w.x = pkbf(v0, v1); w.y = pkbf(v2, v3);
        *(u32x2*)(MIX + tok * DM + d0) = w;
    }
    sq += __shfl_xor(sq, 16); sq += __shfl_xor(sq, 32); if (fq == 0) ss_add(ssa + tok, sq);
    __syncthreads();
}
constexpr int LDS_VN0 = LDS_BT + 2048;
static_assert(LDS_VN0 + 4 * 64 * VN_STRIDE * 2 <= LDS_BYTES - 16, "mixer LDS map");
__device__ __forceinline__ void mixer_phase256(const Args& A, int l, int vc, const bf16* Z, bf16* MIX, ss_t* ssa, ss_t* ssb, unsigned char* lds, int tid, int wid, int lane) {
    bf16* KS = (bf16*)(lds + LDS_KS); bf16* VT = (bf16*)(lds + LDS_VT); float* BT = (float*)(lds + LDS_BT); bf16* VN = (bf16*)(lds + LDS_VN0);
    const int gx = vc & 7, gj = vc >> 3;
    const int n = 8 * gx + (gj >> 2), kvh = gj & 3, h = gj & 15, cb = 8 * gx + 4 * (gj >> 4);
    const int fr = lane & 15, fq = lane >> 4;
    const bool isK = tid < 256; const int arow = tid & 255; const int atok = (n - 1) * 128 + arow;
    u32x4 aw[8], sw[8];
    { const bf16* ap = Z + (size_t)(atok < 0 ? 0 : atok) * INW + (isK ? KCOL : VCOL) + kvh * 64;
#pragma unroll
      for (int c = 0; c < 8; ++c) aw[c] = *(const u32x4*)(ap + 8 * c); }
    const int srow = tid & 127, sj = tid >> 7;
    { const bf16* sp = Z + (size_t)((cb + sj) * 128 + srow) * INW + 1024 + h * 64;
#pragma unroll
      for (int c = 0; c < 8; ++c) sw[c] = *(const u32x4*)(sp + 8 * c); }
    const int st = 16 * wid + fr; const int nks = (wid >> 1) + 1;
    const float* wrow = A.sgu_w + ((size_t)(l * 16 + h) * 128 + st) * 128;
    f32x4 wa[4][2];
#pragma unroll
    for (int ks = 0; ks < 4; ++ks) { wa[ks][0] = (f32x4){0.f, 0.f, 0.f, 0.f}; wa[ks][1] = wa[ks][0];
        if (ks < nks) { wa[ks][0] = *(const f32x4*)(wrow + 32 * ks + 8 * fq); wa[ks][1] = *(const f32x4*)(wrow + 32 * ks + 8 * fq + 4); } }
    const float sbias = A.sgu_b[(l * 16 + h) * 128 + st];
    { const int g = tid >> 7, dist = tid & 127; BT[g * 128 + dist] = A.rel_bias[t5_bucket(dist) * 16 + kvh * 4 + g] * 1.4426950408889634f; }
    if (atok < 0) {
#pragma unroll
        for (int c = 0; c < 8; ++c) aw[c] = (u32x4){0u, 0u, 0u, 0u}; }
    if (isK) {
        const float* gk = A.k_norm_g + l * 64; float ss = 0.f;
#pragma unroll
        for (int c = 0; c < 8; ++c)
#pragma unroll
            for (int e = 0; e < 4; ++e) { const float a = bflo(aw[c][e]), b = bfhi(aw[c][e]); ss += a * a + b * b; }
        const float rstd = 1.0f / sqrtf(ss * (1.0f / 64.f) + EPS);
#pragma unroll
        for (int c = 0; c < 8; ++c) { const f32x4 g0 = *(const f32x4*)(gk + 8 * c), g1 = *(const f32x4*)(gk + 8 * c + 4); u32x4 o;
            o.x = pkbf(bflo(aw[c].x) * rstd * g0.x, bfhi(aw[c].x) * rstd * g0.y); o.y = pkbf(bflo(aw[c].y) * rstd * g0.z, bfhi(aw[c].y) * rstd * g0.w);
            o.z = pkbf(bflo(aw[c].z) * rstd * g1.x, bfhi(aw[c].z) * rstd * g1.y); o.w = pkbf(bflo(aw[c].w) * rstd * g1.z, bfhi(aw[c].w) * rstd * g1.w);
            *(u32x4*)(KS + arow * KS_STRIDE + 8 * c) = o; }
    } else {
#pragma unroll
        for (int c = 0; c < 8; ++c)
#pragma unroll
            for (int e = 0; e < 4; ++e) { VT[(8 * c + 2 * e) * VT_STRIDE + arow] = (bf16)(aw[c][e] & 0xffffu); VT[(8 * c + 2 * e + 1) * VT_STRIDE + arow] = (bf16)(aw[c][e] >> 16); }
    }
    { const float* gs = A.sgu_norm_g + (l * 16 + h) * 64; float ss = 0.f; bf16* vn = VN + sj * 64 * VN_STRIDE;
#pragma unroll
      for (int c = 0; c < 8; ++c)
#pragma unroll
          for (int e = 0; e < 4; ++e) { const float a = bflo(sw[c][e]), b = bfhi(sw[c][e]); ss += a * a + b * b; }
      const float rstd = 1.0f / sqrtf(ss * (1.0f / 64.f) + EPS);
#pragma unroll
      for (int c = 0; c < 8; ++c) { const f32x4 g0 = *(const f32x4*)(gs + 8 * c), g1 = *(const f32x4*)(gs + 8 * c + 4); const float gg[8] = {g0.x, g0.y, g0.z, g0.w, g1.x, g1.y, g1.z, g1.w};
#pragma unroll
          for (int e = 0; e < 4; ++e) { const unsigned w = pkbf(bflo(sw[c][e]) * rstd * gg[2 * e], bfhi(sw[c][e]) * rstd * gg[2 * e + 1]);
              vn[(8 * c + 2 * e) * VN_STRIDE + srow] = (bf16)(w & 0xffffu); vn[(8 * c + 2 * e + 1) * VN_STRIDE + srow] = (bf16)(w >> 16); } }
    }
    asm volatile("" ::: "memory");
    u32x4 q0[2]; attn_load_q(q0, Z, n, kvh, wid, lane);
    u32x2 uw[4][4];
#pragma unroll
    for (int j = 0; j < 4; ++j)
#pragma unroll
        for (int dt = 0; dt < 4; ++dt) uw[j][dt] = *(const u32x2*)(Z + (size_t)((cb + j) * 128 + st) * INW + h * 64 + 16 * dt + 4 * fq);
    __syncthreads();
    {
        bf16x8 bfr[4];
#pragma unroll
        for (int ks = 0; ks < 4; ++ks) { float f[8] = {wa[ks][0].x, wa[ks][0].y, wa[ks][0].z, wa[ks][0].w, wa[ks][1].x, wa[ks][1].y, wa[ks][1].z, wa[ks][1].w}; const int s0 = 32 * ks + 8 * fq;
#pragma unroll
            for (int e = 0; e < 8; ++e) f[e] = (s0 + e <= st) ? f[e] : 0.f;
            u32x4 w; w.x = pkbf(f[0], f[1]); w.y = pkbf(f[2], f[3]); w.z = pkbf(f[4], f[5]); w.w = pkbf(f[6], f[7]); bfr[ks] = __builtin_bit_cast(bf16x8, w); }
#pragma unroll
        for (int j = 0; j < 4; ++j) {
            const bf16* vn = VN + j * 64 * VN_STRIDE; const size_t tok = (size_t)((cb + j) * 128 + st); float sq = 0.f;
#pragma unroll
            for (int dt = 0; dt < 4; ++dt) {
                f32x4 acc = (f32x4){0.f, 0.f, 0.f, 0.f};
#pragma unroll
                for (int ks = 0; ks < 4; ++ks) if (ks < nks) { const bf16x8 a = *(const bf16x8*)(vn + (16 * dt + fr) * VN_STRIDE + 32 * ks + 8 * fq); acc = MFMA16(a, bfr[ks], acc); }
                const float v0 = bflo(uw[j][dt].x) * (acc[0] + sbias), v1 = bfhi(uw[j][dt].x) * (acc[1] + sbias), v2 = bflo(uw[j][dt].y) * (acc[2] + sbias), v3 = bfhi(uw[j][dt].y) * (acc[3] + sbias);
                sq += (v0 * v0 + v1 * v1) + (v2 * v2 + v3 * v3);
                u32x2 w; w.x = pkbf(v0, v1); w.y = pkbf(v2, v3);
                *(u32x2*)(MIX + tok * DM + h * 64 + 16 * dt + 4 * fq) = w;
            }
            sq += __shfl_xor(sq, 16); sq += __shfl_xor(sq, 32); if (fq == 0) ss_add(ssa + tok, sq);
        }
    }
    attn_compute(A, l, n, kvh, q0, Z, MIX, ssb, lds, wid, lane);
}
constexpr int I_IN = (DM / 64) * (INW / 64), I_OUT = (DM / 64) * (DM / 64), I_G = (DM / 64) * (DFF / 64), I_DN = (DFF / 64) * (DM / 64);
constexpr int PER_LAYER = I_IN + I_OUT + 2 * I_G + I_DN;
constexpr int Q_P = 5500, Q_G1 = 4500, Q_G3 = 7000, N_ALL = DEPTH * PER_LAYER;
constexpr bool queue_ok() {
    for (int l = 0; l < DEPTH; ++l) {
        const long c1 = Q_P + (long)l * (Q_G1 + Q_G3) + Q_G1, c3 = Q_P + (long)(l + 1) * (Q_G1 + Q_G3);
        const long r1 = (long)l * PER_LAYER + I_IN + I_OUT + 2 * I_G, r3 = (long)(l + 1) * PER_LAYER + (l + 1 < DEPTH ? I_IN : 0);
        if (c1 < r1 || c3 < r3) return false;
    }
    return Q_P >= I_IN;
}
static_assert(queue_ok(), "conversion queue deadlines");
__device__ __forceinline__ void convert_items(const Args& A, unsigned char* ws, int g0, int g1, int w, int nw, float* scr, int lane) {
    for (int it = g0 + w; it < g1; it += nw) {
        const int l = it / PER_LAYER; int r = it % PER_LAYER;
        if (r < I_IN) { const int nb = INW / 64, kb = r / nb, n0 = 64 * (r % nb); transpose_item(A.w_in + (size_t)l * DM * INW, DM, INW, (bf16*)(ws + WS_WIN + l * SZ_WIN), 64 * kb, n0, n0, A.norm1_g + l * DM + 64 * kb, scr, lane); continue; } r -= I_IN;
        if (r < I_OUT) { const int nb = DM / 64, kb = r / nb, n0 = 64 * (r % nb); transpose_item(A.w_out + (size_t)l * DM * DM, DM, DM, (bf16*)(ws + WS_WOUT + l * SZ_WOUT), 64 * kb, n0, n0, (kb < 16 ? A.out_norm_a + l * 1024 + 64 * kb : A.out_norm_b + l * 1024 + 64 * (kb - 16)), scr, lane); continue; } r -= I_OUT;
        if (r < I_G) { const int nb = DFF / 64, kb = r / nb, n0 = 64 * (r % nb); transpose_item(A.w_gate + (size_t)l * DM * DFF, DM, DFF, (bf16*)(ws + WS_WGU + l * SZ_WGU), 64 * kb, n0, 256 * (n0 / 128) + (n0 % 128), A.norm2_g + l * DM + 64 * kb, scr, lane); continue; } r -= I_G;
        if (r < I_G) { const int nb = DFF / 64, kb = r / nb, n0 = 64 * (r % nb); transpose_item(A.w_up + (size_t)l * DM * DFF, DM, DFF, (bf16*)(ws + WS_WGU + l * SZ_WGU), 64 * kb, n0, 256 * (n0 / 128) + 128 + (n0 % 128), A.norm2_g + l * DM + 64 * kb, scr, lane); continue; } r -= I_G;
        { const int nb = DM / 64, kb = r / nb, n0 = 64 * (r % nb); transpose_item(A.w_down + (size_t)l * DFF * DM, DFF, DM, (bf16*)(ws + WS_WDN + l * SZ_WDN), 64 * kb, n0, n0, nullptr, scr, lane); }
    }
}

__global__ void __launch_bounds__(NWAVES * 64, 2) fwd_kernel(Args A) {
    extern __shared__ __attribute__((aligned(16))) unsigned char lds[];
    cg::grid_group grid = cg::this_grid();
    const int G = gridDim.x, bx = blockIdx.x, NGW = G * NWAVES;
#define PHASE_IDS() int tid = threadIdx.x; asm volatile("" : "+v"(tid)); const int lane = tid & 63, wid = __builtin_amdgcn_readfirstlane(tid >> 6), gw = bx * NWAVES + wid; (void)lane; (void)gw
    unsigned char* ws = A.ws;
    bf16* XB = (bf16*)(ws + WS_XN); ss_t* SS = (ss_t*)(ws + WS_SS); bf16* Z = (bf16*)(ws + WS_Z); bf16* MIX = (bf16*)(ws + WS_MIX); bf16* ACT = (bf16*)(ws + WS_ACT);
    float* X = A.out;
    PG8_LAS unsigned char* ldsl = (PG8_LAS unsigned char*)lds;
    volatile LAS unsigned* bst = (volatile LAS unsigned*)(ldsl + LDS_BYTES - 16);
    if (threadIdx.x < 4) bst[threadIdx.x] = 0u;
    __syncthreads();
    unsigned* barw = (unsigned*)(ws + WS_CTL);
    XcdBarrier bar; bar.bar = barw; bar.st = bst; bar.x = xb_xcc_id();
    if (threadIdx.x == 0) bst[2] = xb_add(&barw[XB_XCNT(bar.x)], 1u);
    __syncthreads();
    const unsigned my_x = bar.x, my_r = (unsigned)__builtin_amdgcn_readfirstlane((int)bst[2]);
#define GRID_BAR() xcd_barrier(bar)

    {
        PHASE_IDS();
        float* scr = (float*)(lds + wid * TSCR);
        const bool lazy = (G == 256);
        convert_items(A, ws, 0, lazy ? Q_P : N_ALL, gw, NGW, scr, lane);
        prologue_rows(A.x, XB, SS + (size_t)SS_Q1 * SEQ, gw, NGW, lane);
    }
    if (A.never) grid.sync();
    GRID_BAR();
    bool tp = (G == 256);
    if (tp) { for (unsigned q = 0; q < 16; ++q) { const unsigned c = xb_ld(&barw[XB_XCNT(q)]); tp = tp && (c == (q < 8 ? 32u : 0u)); } }
    tp = __builtin_amdgcn_readfirstlane((int)tp) != 0;
    const int vc = tp ? (int)(my_r * 8u + my_x) : bx;
#define LOCAL_BAR() do { if (tp) xcc_local_barrier(barw, my_x, 32u); else xcd_barrier(bar); } while (0)

#pragma nounroll
    for (int l = 0; l < DEPTH; ++l) {
        { pg8::Gemm g{XB, (const bf16*)(ws + WS_WIN + l * SZ_WIN), SEQ, INW, DM};
          pg8::EpiZ E{Z, INW, 8, SS + (size_t)(SS_Q1 + l) * SEQ};
          if (G == 256) { pg8::OrderTok S{vc, INW / 256, 0}; pg8::gemm_phase<pg8::EpiZ, pg8::OrderTok, true, true>(ldsl, g, S, E); }
          else { pg8::StaticOrder S; S.init(SEQ, INW, G, bx); pg8::gemm_phase<pg8::EpiZ, pg8::StaticOrder, true, true>(ldsl, g, S, E); } }
        if (G == 256 && vc >= 192) {
            PHASE_IDS(); const int g0 = Q_P + l * (Q_G1 + Q_G3), g1 = g0 + Q_G1;
            convert_items(A, ws, g0 < N_ALL ? g0 : N_ALL, g1 < N_ALL ? g1 : N_ALL, (vc - 192) * NWAVES + wid, 64 * NWAVES, (float*)(lds + wid * TSCR), lane); }
        GRID_BAR();
        { PHASE_IDS();
          if (G == 256) mixer_phase256(A, l, vc, Z, MIX, SS + (size_t)(SS_A + l) * SEQ, SS + (size_t)(SS_B + l) * SEQ, lds, tid, wid, lane);
          else {
            for (int a = bx; a < 256; a += G) attn_unit(A, l, a >> 2, a & 3, Z, MIX, SS + (size_t)(SS_B + l) * SEQ, lds, tid, wid, lane);
            for (int s = bx; s < 1024; s += G) sgu_unit(A, l, s >> 4, s & 15, Z, MIX, SS + (size_t)(SS_A + l) * SEQ, lds, tid, wid, lane); } }
        LOCAL_BAR();
        { pg8::Gemm g{MIX, (const bf16*)(ws + WS_WOUT + l * SZ_WOUT), SEQ, DM, DM};
          pg8::EpiResid<true> E{nullptr, DM, XB, SS + (size_t)(SS_Q2 + l) * SEQ, SS + (size_t)(SS_A + l) * SEQ, SS + (size_t)(SS_B + l) * SEQ};
          if (G == 256) { pg8::OrderTok S{vc, DM / 256, 0}; pg8::gemm_phase<pg8::EpiResid<true>, pg8::OrderTok, true, true>(ldsl, g, S, E); }
          else { pg8::StaticOrder S; S.init(SEQ, DM, G, bx); pg8::gemm_phase<pg8::EpiResid<true>, pg8::StaticOrder, true, true>(ldsl, g, S, E); } }
        LOCAL_BAR();
        { pg8::Gemm g{XB, (const bf16*)(ws + WS_WGU + l * SZ_WGU), SEQ, NGU, DM};
          pg8::EpiSwiGLU E{ACT, DFF, SS + (size_t)(SS_Q2 + l) * SEQ};
          if (G == 256) { pg8::OrderTok S{vc, NGU / 256, 5}; pg8::gemm_phase<pg8::EpiSwiGLU, pg8::OrderTok, true, true>(ldsl, g, S, E); }
          else { pg8::StaticOrder S; S.init(SEQ, NGU, G, bx); pg8::gemm_phase<pg8::EpiSwiGLU, pg8::StaticOrder, true, true>(ldsl, g, S, E); } }
        if (G == 256 && vc >= 128) {
            PHASE_IDS(); const int g0 = Q_P + l * (Q_G1 + Q_G3) + Q_G1, g1 = g0 + Q_G3;
            convert_items(A, ws, g0 < N_ALL ? g0 : N_ALL, g1 < N_ALL ? g1 : N_ALL, (vc - 128) * NWAVES + wid, 128 * NWAVES, (float*)(lds + wid * TSCR), lane); }
        GRID_BAR();
        { pg8::Gemm g{ACT, (const bf16*)(ws + WS_WDN + l * SZ_WDN), SEQ, DM, DFF};
          const bool more = l + 1 < DEPTH;
          pg8::EpiResid<false> E{more ? nullptr : X, DM, XB, SS + (size_t)(SS_Q1 + (more ? l + 1 : 0)) * SEQ, nullptr, nullptr};
          if (G == 256) { pg8::OrderTok S{vc, DM / 256, 0}; pg8::gemm_phase<pg8::EpiResid<false>, pg8::OrderTok, true, true>(ldsl, g, S, E); }
          else { pg8::StaticOrder S; S.init(SEQ, DM, G, bx); pg8::gemm_phase<pg8::EpiResid<false>, pg8::StaticOrder, true, true>(ldsl, g, S, E); } }
        if (l + 1 < DEPTH) LOCAL_BAR();
    }
}

extern "C" void kernel_launch(void* const* d_in, const int* in_sizes, int n_in, void* d_out, int out_size, void* d_ws, size_t ws_size, hipStream_t stream) {
    static int grid = 0;
    if (grid == 0) {
        if (n_in != 17 || out_size != SEQ * DM || ws_size < WS_END) { fprintf(stderr, "kernel_launch: unexpected shapes n_in %d out %d ws %zu (need %zu)\n", n_in, out_size, ws_size, (size_t)WS_END); grid = -1; return; }
        int dev = 0, cus = 0, per_cu = 0;
        (void)hipGetDevice(&dev); (void)hipDeviceGetAttribute(&cus, hipDeviceAttributeMultiprocessorCount, dev);
        (void)hipFuncSetAttribute((const void*)fwd_kernel, hipFuncAttributeMaxDynamicSharedMemorySize, LDS_BYTES);
        (void)hipOccupancyMaxActiveBlocksPerMultiprocessor(&per_cu, (const void*)fwd_kernel, NWAVES * 64, LDS_BYTES);
        if (per_cu < 1) { fprintf(stderr, "kernel_launch: occupancy query says %d blocks per CU\n", per_cu); per_cu = 1; }
        grid = cus * per_cu;
        fprintf(stderr, "kernel_launch: grid %d (cus %d x %d), ws %zu need %zu\n", grid, cus, per_cu, ws_size, (size_t)WS_END);
    }
    if (grid < 0) return;
    Args a{};
    a.x = (const float*)d_in[0]; a.rel_bias = (const float*)d_in[1]; a.norm1_g = (const float*)d_in[2]; a.w_in = (const float*)d_in[3]; a.sgu_norm_g = (const float*)d_in[4];
    a.sgu_w = (const float*)d_in[5]; a.sgu_b = (const float*)d_in[6]; a.q_norm_g = (const float*)d_in[7]; a.k_norm_g = (const float*)d_in[8]; a.sinks = (const float*)d_in[9];
    a.out_norm_a = (const float*)d_in[10]; a.out_norm_b = (const float*)d_in[11]; a.w_out = (const float*)d_in[12]; a.norm2_g = (const float*)d_in[13];
    a.w_gate = (const float*)d_in[14]; a.w_up = (const float*)d_in[15]; a.w_down = (const float*)d_in[16];
    a.out = (float*)d_out; a.ws = (unsigned char*)d_ws;
    (void)hipMemsetAsync((char*)d_ws + WS_CTL, 0, CTL_ZERO_BYTES, stream);
    void* args[] = {&a};
    hipError_t e = hipLaunchCooperativeKernel((const void*)fwd_kernel, dim3(grid), dim3(NWAVES * 64), args, LDS_BYTES, stream);
    if (e != hipSuccess) fprintf(stderr, "kernel_launch: cooperative launch failed: %s (grid %d)\n", hipGetErrorString(e), grid);
}
```
